# Optimizing an MI355X kernel written in HIP

```python
import math
import jax, jax.numpy as jnp
from jax import lax
import numpy as np

D_MODEL = 1024
BATCH = 8
SEQ = 2048
DEPTH = 1

RET_HEADS = 4
RET_DK = 256
RET_DV = 512
RET_CHUNK = 128
RET_QK_W = RET_HEADS * RET_DK
RET_V_W = RET_HEADS * RET_DV
ATT_GROUPS = ((128, 1), (512, 4), (2048, 16))
N_ATT_GROUPS = len(ATT_GROUPS)
ATT_HEADS_PER_GROUP = 4
ATT_HEAD_DIM = 128
ATT_GROUP_W = ATT_HEADS_PER_GROUP * ATT_HEAD_DIM
N_ATT_HEADS = N_ATT_GROUPS * ATT_HEADS_PER_GROUP
REL_BUCKETS = 32
REL_MAX_DIST = 2048
D_FF = 4 * D_MODEL
N_BRANCHES = 2
RMS_EPS = 1e-6
GN_EPS = 1e-5
ROPE_BASE = 10000.0

IN_SIZES = ([RET_QK_W, RET_QK_W, RET_V_W, RET_V_W]
            + [ATT_GROUP_W] * (3 * N_ATT_GROUPS)
            + [D_MODEL] * N_BRANCHES)
IN_COLS = sum(IN_SIZES)
IN_OFFSETS = [sum(IN_SIZES[:i + 1]) for i in range(len(IN_SIZES) - 1)]

kernel_name = "hybrid_retention_dilated_attn_block"


def rms_norm(x, g):
    xf = x.astype(jnp.float32)
    y = xf * lax.rsqrt(jnp.mean(xf * xf, axis=-1, keepdims=True) + RMS_EPS)
    return (y * g.astype(jnp.float32)).astype(x.dtype)


def modulate(h, shift, scale):
    return h * (1 + scale[:, None, :]) + shift[:, None, :]


def t5_bucket(dist):
    max_exact = REL_BUCKETS // 2
    d_f = jnp.maximum(dist, 1).astype(jnp.float32)
    large = max_exact + (jnp.log(d_f / max_exact) / math.log(REL_MAX_DIST / max_exact)
                         * (REL_BUCKETS - max_exact)).astype(jnp.int32)
    large = jnp.minimum(large, REL_BUCKETS - 1)
    return jnp.where(dist < max_exact, dist, large)


def rotary(x, pos):
    half = x.shape[-1] // 2
    inv = ROPE_BASE ** (-jnp.arange(half, dtype=jnp.float32) / half)
    ang = pos.astype(jnp.float32)[:, None] * inv[None, :]
    cos, sin = jnp.cos(ang).astype(x.dtype), jnp.sin(ang).astype(x.dtype)
    x1, x2 = x[..., :half], x[..., half:]
    return jnp.concatenate([x1 * cos - x2 * sin, x1 * sin + x2 * cos], axis=-1)


def retention(q, k, v):
    B, H, S, dk = q.shape
    dv = v.shape[-1]
    C = RET_CHUNK
    nc = S // C
    log_g = jnp.log1p(-(2.0 ** (-5.0 - jnp.arange(H, dtype=jnp.float32))))
    idx = jnp.arange(C, dtype=jnp.float32)
    rel = idx[:, None] - idx[None, :]
    inner_decay = jnp.where(rel >= 0, jnp.exp(log_g[:, None, None] * jnp.maximum(rel, 0.0)), 0.0)
    q_decay = jnp.exp(log_g[:, None] * (idx + 1.0))
    k_decay = jnp.exp(log_g[:, None] * (C - 1.0 - idx))
    chunk_decay = jnp.exp(log_g * C)

    def to_chunks(t):
        return jnp.moveaxis(t.astype(jnp.float32).reshape(B, H, nc, C, t.shape[-1]), 2, 0)

    qc, kc, vc = to_chunks(q), to_chunks(k), to_chunks(v)

    def step(state, inp):
        qi, ki, vi = inp
        s = jnp.einsum('bhid,bhjd->bhij', qi, ki) * inner_decay[None]
        o = (jnp.einsum('bhij,bhje->bhie', s, vi)
             + jnp.einsum('bhid,bhde->bhie', qi, state) * q_decay[None, :, :, None])
        state = (state * chunk_decay[None, :, None, None]
                 + jnp.einsum('bhjd,bhje->bhde', ki * k_decay[None, :, :, None], vi))
        return state, o

    state0 = jnp.zeros((B, H, dk, dv), jnp.float32)
    _, o = lax.scan(step, state0, (qc, kc, vc))
    return jnp.moveaxis(o, 0, 2).reshape(B, H, S, dv)


def dilated_group(q, k, v, bias_tab, window, dilation):
    B, H, S, dh = q.shape
    w = window // dilation
    blk = w
    span = dilation * blk
    Sp = -(-S // span) * span
    L = Sp // dilation
    nb = L // blk

    def split(t):
        t = jnp.pad(t, ((0, 0), (0, 0), (0, Sp - S), (0, 0)))
        t = t.reshape(B, H, L, dilation, dh).transpose(0, 1, 3, 2, 4)
        return t.reshape(B, H, dilation, nb, blk, dh)

    qs, ks, vs = split(q), split(k), split(v)

    def with_prev(t):
        prev = jnp.pad(t[:, :, :, :-1], ((0, 0), (0, 0), (0, 0), (1, 0), (0, 0), (0, 0)))
        return jnp.concatenate([prev, t], axis=4)

    kb, vb = with_prev(ks), with_prev(vs)
    qi = jnp.arange(blk)[:, None]
    kj = jnp.arange(2 * blk)[None, :]
    m = blk + qi - kj
    band = (m >= 0) & (m <= w)
    first_ok = kj >= blk
    valid = band[None] & ((jnp.arange(nb)[:, None, None] > 0) | first_ok[None])
    bias = bias_tab[t5_bucket(jnp.clip(m, 0, w) * dilation)]
    bias = jnp.moveaxis(bias, -1, 0).astype(jnp.float32)

    s = (jnp.einsum('bhrnid,bhrnjd->bhrnij', qs, kb).astype(jnp.float32) * (dh ** -0.5)
         + bias[None, :, None, None])
    s = jnp.where(valid[None, None, None], s, -1e30)
    mx = jnp.max(s, axis=-1, keepdims=True)
    e = jnp.exp(s - mx)
    den = jnp.sum(e, axis=-1, keepdims=True)
    p = (e / den).astype(v.dtype)
    lse = (mx + jnp.log(den))[..., 0]
    o = jnp.einsum('bhrnij,bhrnjd->bhrnid', p, vb)

    def merge(t):
        t = t.reshape(B, H, dilation, L, *t.shape[5:])
        t = jnp.swapaxes(t, 2, 3)
        t = t.reshape(B, H, Sp, *t.shape[4:])
        return t[:, :, :S]

    return merge(o), merge(lse)


def token_mixer(h, w_in, rel_bias, gn_g, gn_b, w_ret_out, w_att_out, w_o):
    B, S, _ = h.shape
    proj = h @ w_in
    parts = jnp.split(proj, IN_OFFSETS, axis=-1)

    def heads(t, n):
        return t.reshape(B, S, n, -1).transpose(0, 2, 1, 3)

    pos = jnp.arange(S)
    rq, rk, rv, rg = parts[0], parts[1], parts[2], parts[3]
    rq = rotary(heads(rq, RET_HEADS), pos)
    rk = rotary(heads(rk, RET_HEADS), pos) * (RET_DK ** -0.5)
    ro = retention(rq, rk, heads(rv, RET_HEADS))
    mu = jnp.mean(ro, axis=-1, keepdims=True)
    var = jnp.mean(jnp.square(ro - mu), axis=-1, keepdims=True)
    ro = ((ro - mu) * lax.rsqrt(var + GN_EPS)).transpose(0, 2, 1, 3).reshape(B, S, RET_V_W)
    ro = (ro * gn_g.astype(jnp.float32) + gn_b.astype(jnp.float32)).astype(h.dtype)
    ret_out = (jax.nn.silu(rg) * ro) @ w_ret_out

    outs, lses = [], []
    for gi, (win, dil) in enumerate(ATT_GROUPS):
        aq, ak, av = parts[4 + 3 * gi], parts[5 + 3 * gi], parts[6 + 3 * gi]
        tab = rel_bias[:, gi * ATT_HEADS_PER_GROUP:(gi + 1) * ATT_HEADS_PER_GROUP]
        o, lse = dilated_group(heads(aq, ATT_HEADS_PER_GROUP), heads(ak, ATT_HEADS_PER_GROUP),
                               heads(av, ATT_HEADS_PER_GROUP), tab, win, dil)
        outs.append(o)
        lses.append(lse)
    o_all = jnp.stack(outs, axis=0)
    wts = jax.nn.softmax(jnp.stack(lses, axis=0), axis=0)
    att = jnp.einsum('gbhs,gbhsd->bshd', wts.astype(o_all.dtype), o_all).reshape(B, S, ATT_GROUP_W)
    att_out = att @ w_att_out

    gate_a, gate_b = parts[-2], parts[-1]
    merged = jax.nn.sigmoid(gate_a) * ret_out + jax.nn.sigmoid(gate_b) * att_out
    return merged @ w_o


def squared_relu_mlp(h, w1, w2):
    return jnp.square(jax.nn.relu(h @ w1)) @ w2


def setup_inputs(seed: int = 0) -> dict:
    key = jax.random.key(seed)
    ks = jax.random.split(key, 18)
    nrm = jax.random.normal
    f32 = jnp.float32
    return {
        "x": nrm(ks[0], (BATCH, SEQ, D_MODEL), f32),
        "c": nrm(ks[1], (BATCH, D_MODEL), f32),
        "w_ada": nrm(ks[2], (DEPTH, D_MODEL, 6 * D_MODEL), f32) * D_MODEL ** -0.5,
        "b_ada": nrm(ks[3], (DEPTH, 6 * D_MODEL), f32) * 0.02,
        "norm1_g": 1.0 + 0.02 * nrm(ks[4], (DEPTH, D_MODEL), f32),
        "w_in": nrm(ks[5], (DEPTH, D_MODEL, IN_COLS), f32) * D_MODEL ** -0.5,
        "rel_bias": nrm(ks[6], (REL_BUCKETS, N_ATT_HEADS), f32) * 0.5,
        "ret_gn_g": 1.0 + 0.02 * nrm(ks[7], (DEPTH, RET_V_W), f32),
        "ret_gn_b": 0.02 * nrm(ks[8], (DEPTH, RET_V_W), f32),
        "w_ret_out": nrm(ks[9], (DEPTH, RET_V_W, D_MODEL), f32) * RET_V_W ** -0.5,
        "w_att_out": nrm(ks[10], (DEPTH, ATT_GROUP_W, D_MODEL), f32) * ATT_GROUP_W ** -0.5,
        "w_o": nrm(ks[11], (DEPTH, D_MODEL, D_MODEL), f32) * D_MODEL ** -0.5,
        "norm2_g": 1.0 + 0.02 * nrm(ks[12], (DEPTH, D_MODEL), f32),
        "w_ff1": nrm(ks[13], (DEPTH, D_MODEL, D_FF), f32) * D_MODEL ** -0.5,
        "w_ff2": nrm(ks[14], (DEPTH, D_FF, D_MODEL), f32) * D_FF ** -0.5,
        "norm_f_g": 1.0 + 0.02 * nrm(ks[15], (D_MODEL,), f32),
    }


def reference(x, c, w_ada, b_ada, norm1_g, w_in, rel_bias, ret_gn_g, ret_gn_b,
              w_ret_out, w_att_out, w_o, norm2_g, w_ff1, w_ff2, norm_f_g):
    for l in range(DEPTH):
        mod = jax.nn.silu(c) @ w_ada[l] + b_ada[l]
        sh1, sc1, g1, sh2, sc2, g2 = jnp.split(mod, 6, axis=-1)
        h = modulate(rms_norm(x, norm1_g[l]), sh1, sc1)
        x = x + g1[:, None, :] * token_mixer(h, w_in[l], rel_bias, ret_gn_g[l], ret_gn_b[l],
                                             w_ret_out[l], w_att_out[l], w_o[l])
        h = modulate(rms_norm(x, norm2_g[l]), sh2, sc2)
        x = x + g2[:, None, :] * squared_relu_mlp(h, w_ff1[l], w_ff2[l])
    return rms_norm(x, norm_f_g)
```

```cpp
#include <hip/hip_runtime.h>
#include <cstdio>
#include <cstdint>

namespace v0 {
constexpr int D = 1024, NB = 8, S = 2048, M = NB * S, INC = 12800, FF = 4096;
constexpr float RMS_EPS = 1e-6f, GN_EPS = 1e-5f;

template <class Epi>
__global__ void __launch_bounds__(256) sgemm(const float* __restrict__ A, const float* __restrict__ Bm, int lda, int ldb, int Kk, int pad_, Epi epi) {
    __shared__ float As[16][128 + 4];
    __shared__ float Bs[16][128 + 4];
    const int t = threadIdx.x, tx = t & 15, ty = t >> 4;
    const int m0 = blockIdx.y * 128, n0 = blockIdx.x * 128;
    float acc[8][8];
#pragma unroll
    for (int i = 0; i < 8; ++i)
#pragma unroll
        for (int j = 0; j < 8; ++j) acc[i][j] = 0.f;
    const int ar = t >> 1, ak = (t & 1) * 8;
    const int bk = t >> 4, bn = (t & 15) * 8;
    for (int k0 = 0; k0 < Kk; k0 += 16) {
        const float4 a0 = *(const float4*)(A + (size_t)(m0 + ar) * lda + k0 + ak);
        const float4 a1 = *(const float4*)(A + (size_t)(m0 + ar) * lda + k0 + ak + 4);
        const float4 b0 = *(const float4*)(Bm + (size_t)(k0 + bk) * ldb + n0 + bn);
        const float4 b1 = *(const float4*)(Bm + (size_t)(k0 + bk) * ldb + n0 + bn + 4);
        __syncthreads();
        As[ak + 0][ar] = a0.x; As[ak + 1][ar] = a0.y; As[ak + 2][ar] = a0.z; As[ak + 3][ar] = a0.w;
        As[ak + 4][ar] = a1.x; As[ak + 5][ar] = a1.y; As[ak + 6][ar] = a1.z; As[ak + 7][ar] = a1.w;
        *(float4*)&Bs[bk][bn] = b0; *(float4*)&Bs[bk][bn + 4] = b1;
        __syncthreads();
#pragma unroll
        for (int kk = 0; kk < 16; ++kk) {
            const float4 x0 = *(const float4*)&As[kk][ty * 4], x1 = *(const float4*)&As[kk][64 + ty * 4];
            const float4 y0 = *(const float4*)&Bs[kk][tx * 4], y1 = *(const float4*)&Bs[kk][64 + tx * 4];
            const float xa[8] = {x0.x, x0.y, x0.z, x0.w, x1.x, x1.y, x1.z, x1.w};
            const float yb[8] = {y0.x, y0.y, y0.z, y0.w, y1.x, y1.y, y1.z, y1.w};
#pragma unroll
            for (int i = 0; i < 8; ++i)
#pragma unroll
                for (int j = 0; j < 8; ++j) acc[i][j] = fmaf(xa[i], yb[j], acc[i][j]);
        }
    }
#pragma unroll
    for (int i = 0; i < 8; ++i) {
        const int r = m0 + (i < 4 ? ty * 4 + i : 64 + ty * 4 + (i - 4));
#pragma unroll
        for (int j = 0; j < 8; ++j) {
            const int c = n0 + (j < 4 ? tx * 4 + j : 64 + tx * 4 + (j - 4));
            epi(r, c, acc[i][j]);
        }
    }
}

struct EStore { float* C; int ldc; int pad; __device__ void operator()(int r, int c, float v) const { C[(size_t)r * ldc + c] = v; } };
struct EMulSilu { float* C; int ldc; int pad; __device__ void operator()(int r, int c, float v) const { float* p = C + (size_t)r * ldc + c; *p = (v / (1.f + expf(-v))) * *p; } };
struct EAcc { float* C; int ldc; int first; __device__ void operator()(int r, int c, float v) const { float* p = C + (size_t)r * ldc + c; *p = first ? v : *p + v; } };
struct EGateA { float* C; int ldc; int pad; __device__ void operator()(int r, int c, float v) const { float* p = C + (size_t)r * ldc + c; *p = (1.f / (1.f + expf(-v))) * *p; } };
struct EGateB { float* C; const float* T; int ldc; int pad; __device__ void operator()(int r, int c, float v) const { float* p = C + (size_t)r * ldc + c; *p = *p + (1.f / (1.f + expf(-v))) * T[(size_t)r * ldc + c]; } };
struct EResid { const float* x; const float* g; float* out; __device__ void operator()(int r, int c, float v) const { const int b = r / S; out[(size_t)r * D + c] = x[(size_t)r * D + c] + g[b * 6 * D + c] * v; } };
struct EReluSq { float* C; int ldc; int pad; __device__ void operator()(int r, int c, float v) const { const float a = v > 0.f ? v : 0.f; C[(size_t)r * ldc + c] = a * a; } };
struct EFfn2 { float* C; const float* x1; const float* g; int mode; int pad;
    __device__ void operator()(int r, int c, float v) const { float* p = C + (size_t)r * D + c;
        if (mode == 0) *p = v; else if (mode == 1) *p = *p + v; else { const int b = r / S; *p = x1[(size_t)r * D + c] + g[b * 6 * D + c] * (*p + v); } } };

template <class Epi> static void gemm(hipStream_t st, const float* A, int lda, const float* Bm, int ldb, int Mm, int Nn, int Kk, Epi e) {
    sgemm<Epi><<<dim3(Nn / 128, Mm / 128), 256, 0, st>>>(A, Bm, lda, ldb, Kk, 0, e);
}

__global__ void k_mod(const float* __restrict__ c, const float* __restrict__ w, const float* __restrict__ bias, float* __restrict__ mod) {
    const int n = blockIdx.x * 256 + threadIdx.x, b = blockIdx.y;
    float acc = 0.f;
    for (int k = 0; k < D; ++k) { const float cv = c[b * D + k]; acc = fmaf(cv / (1.f + expf(-cv)), w[(size_t)k * 6 * D + n], acc); }
    mod[b * 6 * D + n] = acc + bias[n];
}
__device__ __forceinline__ float block_sum256(float v, float* sh) {
#pragma unroll
    for (int o = 32; o > 0; o >>= 1) v += __shfl_xor(v, o);
    __syncthreads();
    if ((threadIdx.x & 63) == 0) sh[threadIdx.x >> 6] = v;
    __syncthreads();
    return sh[0] + sh[1] + sh[2] + sh[3];
}
__global__ void __launch_bounds__(256) k_norm(const float* __restrict__ x, const float* __restrict__ g, const float* __restrict__ shift, const float* __restrict__ scale, float* __restrict__ out) {
    __shared__ float sh[4];
    const int r = blockIdx.x, b = r / S, t = threadIdx.x;
    const float4 v = *(const float4*)(x + (size_t)r * D + t * 4);
    const float ss = block_sum256(v.x * v.x + v.y * v.y + v.z * v.z + v.w * v.w, sh);
    const float rstd = rsqrtf(ss * (1.f / D) + RMS_EPS);
    const float4 gv = *(const float4*)(g + t * 4);
    float4 o = {v.x * rstd * gv.x, v.y * rstd * gv.y, v.z * rstd * gv.z, v.w * rstd * gv.w};
    if (shift) {
        const float4 sc = *(const float4*)(scale + b * 6 * D + t * 4), sf = *(const float4*)(shift + b * 6 * D + t * 4);
        o.x = o.x * (1.f + sc.x) + sf.x; o.y = o.y * (1.f + sc.y) + sf.y; o.z = o.z * (1.f + sc.z) + sf.z; o.w = o.w * (1.f + sc.w) + sf.w;
    }
    *(float4*)(out + (size_t)r * D + t * 4) = o;
}
__global__ void k_rotary(float* __restrict__ buf, float scale) {
    const int idx = blockIdx.x * 256 + threadIdx.x;
    const int r = idx >> 7, i = idx & 127, pos = r % S;
    const float inv = powf(10000.0f, -(float)i / 128.0f);
    const float ang = (float)pos * inv;
    const float cs = cosf(ang), sn = sinf(ang);
    float* p = buf + (size_t)r * 256 + i;
    const float x1 = p[0], x2 = p[128];
    p[0] = (x1 * cs - x2 * sn) * scale; p[128] = (x1 * sn + x2 * cs) * scale;
}
__global__ void __launch_bounds__(256) k_retention(const float* __restrict__ q, const float* __restrict__ k, const float* __restrict__ v, float* __restrict__ o, float gamma) {
    __shared__ float qs[256], ks[256], red[16][17];
    const int b = blockIdx.y, e0 = blockIdx.x * 16, t = threadIdx.x, el = t & 15, dg = t >> 4;
    float st[16];
#pragma unroll
    for (int i = 0; i < 16; ++i) st[i] = 0.f;
    for (int s = 0; s < S; ++s) {
        const size_t row = (size_t)b * S + s;
        __syncthreads();
        qs[t] = q[row * 256 + t]; ks[t] = k[row * 256 + t];
        const float vv = v[row * 512 + e0 + el];
        __syncthreads();
        float part = 0.f;
#pragma unroll
        for (int i = 0; i < 16; ++i) { const int d = dg * 16 + i; st[i] = fmaf(gamma, st[i], ks[d] * vv); part = fmaf(qs[d], st[i], part); }
        red[dg][el] = part;
        __syncthreads();
        if (t < 16) { float a = 0.f;
#pragma unroll
            for (int j = 0; j < 16; ++j) a += red[j][t];
            o[row * 512 + e0 + t] = a; }
    }
}
__global__ void __launch_bounds__(256) k_gn(float* __restrict__ o, const float* __restrict__ g, const float* __restrict__ bb) {
    __shared__ float sh[4];
    const int r = blockIdx.x, t = threadIdx.x;
    float* p = o + (size_t)r * 512;
    const float a = p[t], c = p[t + 256];
    const float mu = block_sum256(a + c, sh) * (1.f / 512.f);
    const float da = a - mu, dc = c - mu;
    const float var = block_sum256(da * da + dc * dc, sh) * (1.f / 512.f);
    const float rs = rsqrtf(var + GN_EPS);
    p[t] = da * rs * g[t] + bb[t]; p[t + 256] = dc * rs * g[t + 256] + bb[t + 256];
}
__device__ __forceinline__ int t5_bucket(int dist) {
    if (dist < 16) return dist;
    return 16 + (dist >= 22) + (dist >= 30) + (dist >= 40) + (dist >= 54) + (dist >= 73) + (dist >= 99) + (dist >= 134) + (dist >= 182) + (dist >= 246) + (dist >= 332)
         + (dist >= 450) + (dist >= 609) + (dist >= 825) + (dist >= 1117) + (dist >= 1513);
}
__global__ void __launch_bounds__(128) k_attn(const float* __restrict__ q, const float* __restrict__ k, const float* __restrict__ v, const float* __restrict__ tab  , int col, int dil,
                                              float* __restrict__ o, float* __restrict__ lse) {
    __shared__ float qs[128], ps[132], sh[2];
    const int row = blockIdx.x, b = row / S, tq = row % S, t = threadIdx.x, p = tq / dil;
    qs[t] = q[(size_t)row * 128 + t];
    __syncthreads();
    float sc[2];
#pragma unroll
    for (int u = 0; u < 2; ++u) {
        const int m = t + u * 128;
        float s = -1e30f;
        if (m <= 128 && (u == 0 || t == 0) && p - m >= 0) {
            const float* kr = k + ((size_t)b * S + (tq - m * dil)) * 128;
            float a = 0.f;
            for (int d = 0; d < 128; ++d) a = fmaf(qs[d], kr[d], a);
            s = a * 0.08838834764831845f + tab[t5_bucket(m * dil) * 12 + col];
        }
        sc[u] = s;
    }
    float mx = fmaxf(sc[0], sc[1]);
#pragma unroll
    for (int off = 32; off > 0; off >>= 1) mx = fmaxf(mx, __shfl_xor(mx, off));
    if ((t & 63) == 0) sh[t >> 6] = mx;
    __syncthreads();
    mx = fmaxf(sh[0], sh[1]);
    const float e0 = expf(sc[0] - mx), e1 = (t == 0) ? expf(sc[1] - mx) : 0.f;
    ps[t] = e0; if (t == 0) ps[128] = e1;
    float sum = e0 + e1;
#pragma unroll
    for (int off = 32; off > 0; off >>= 1) sum += __shfl_xor(sum, off);
    __syncthreads();
    if ((t & 63) == 0) sh[t >> 6] = sum;
    __syncthreads();
    const float den = sh[0] + sh[1];
    float acc = 0.f;
    const int mmax = p < 128 ? p : 128;
    for (int m = 0; m <= mmax; ++m) acc = fmaf(ps[m], v[((size_t)b * S + (tq - m * dil)) * 128 + t], acc);
    o[(size_t)row * 128 + t] = acc / den;
    if (t == 0) lse[row] = mx + logf(den);
}
__global__ void k_merge(const float* __restrict__ o0, const float* __restrict__ o1, const float* __restrict__ o2, const float* __restrict__ l0, const float* __restrict__ l1, const float* __restrict__ l2,
                        float* __restrict__ att, int h) {
    const int idx = blockIdx.x * 256 + threadIdx.x, r = idx >> 7, e = idx & 127;
    const float a = l0[r], bq = l1[r], c = l2[r], mx = fmaxf(a, fmaxf(bq, c));
    const float w0 = expf(a - mx), w1 = expf(bq - mx), w2 = expf(c - mx), inv = 1.f / (w0 + w1 + w2);
    att[(size_t)r * 512 + h * 128 + e] = (w0 * o0[idx] + w1 * o1[idx] + w2 * o2[idx]) * inv;
}
}

extern "C" void kernel_launch(void* const* d_in, const int* in_sizes, int n_in, void* d_out, int out_size, void* d_ws, size_t ws_size, hipStream_t stream) {
    using namespace v0;
    const float* x = (const float*)d_in[0]; const float* c = (const float*)d_in[1]; const float* w_ada = (const float*)d_in[2]; const float* b_ada = (const float*)d_in[3];
    const float* norm1_g = (const float*)d_in[4]; const float* w_in = (const float*)d_in[5]; const float* rel_bias = (const float*)d_in[6]; const float* gn_g = (const float*)d_in[7];
    const float* gn_b = (const float*)d_in[8]; const float* w_ret_out = (const float*)d_in[9]; const float* w_att_out = (const float*)d_in[10]; const float* w_o = (const float*)d_in[11];
    const float* norm2_g = (const float*)d_in[12]; const float* w_ff1 = (const float*)d_in[13]; const float* w_ff2 = (const float*)d_in[14]; const float* norm_f_g = (const float*)d_in[15];
    float* out = (float*)d_out;
    float* ws = (float*)d_ws;
    constexpr size_t MiBf = (1u << 20) / 4;
    float* mod = ws;
    float* H = ws + 1 * MiBf;
    float* T1 = ws + 65 * MiBf;
    float* T2 = ws + 129 * MiBf;
    float* T3 = ws + 161 * MiBf;
    float* LSE = ws + 225 * MiBf;

    k_mod<<<dim3(6 * D / 256, NB), 256, 0, stream>>>(c, w_ada, b_ada, mod);
    k_norm<<<M, 256, 0, stream>>>(x, norm1_g, mod + 0 * D, mod + 1 * D, H);
    for (int h = 0; h < 4; ++h) {
        float* q = T1; float* k = T1 + (size_t)M * 256; float* v = T1 + (size_t)M * 512;
        gemm(stream, H, D, w_in + 0 + h * 256, INC, M, 256, D, EStore{q, 256, 0});
        gemm(stream, H, D, w_in + 1024 + h * 256, INC, M, 256, D, EStore{k, 256, 0});
        gemm(stream, H, D, w_in + 2048 + h * 512, INC, M, 512, D, EStore{v, 512, 0});
        k_rotary<<<M * 128 / 256, 256, 0, stream>>>(q, 1.0f);
        k_rotary<<<M * 128 / 256, 256, 0, stream>>>(k, 0.0625f);
        const float gamma = 1.0f - exp2f(-5.0f - (float)h);
        k_retention<<<dim3(512 / 16, NB), 256, 0, stream>>>(q, k, v, T2, gamma);
        k_gn<<<M, 256, 0, stream>>>(T2, gn_g + h * 512, gn_b + h * 512);
        gemm(stream, H, D, w_in + 4096 + h * 512, INC, M, 512, D, EMulSilu{T2, 512, 0});
        gemm(stream, T2, 512, w_ret_out + (size_t)h * 512 * D, D, M, D, 512, EAcc{out, D, h == 0});
    }
    const int dils[3] = {1, 4, 16};
    for (int h = 0; h < 4; ++h) {
        float* q = T1; float* k = T1 + (size_t)M * 128; float* v = T1 + (size_t)M * 256;
        float* og[3] = {T1 + (size_t)M * 384, T1 + (size_t)M * 512, T1 + (size_t)M * 640};
        for (int g = 0; g < 3; ++g) {
            const int cb = 6144 + 3 * g * 512 + h * 128;
            gemm(stream, H, D, w_in + cb, INC, M, 128, D, EStore{q, 128, 0});
            gemm(stream, H, D, w_in + cb + 512, INC, M, 128, D, EStore{k, 128, 0});
            gemm(stream, H, D, w_in + cb + 1024, INC, M, 128, D, EStore{v, 128, 0});
            k_attn<<<M, 128, 0, stream>>>(q, k, v, rel_bias, g * 4 + h, dils[g], og[g], LSE + (size_t)g * M);
        }
        k_merge<<<M * 128 / 256, 256, 0, stream>>>(og[0], og[1], og[2], LSE, LSE + M, LSE + 2 * (size_t)M, T2, h);
    }
    gemm(stream, T2, 512, w_att_out, D, M, D, 512, EStore{T3, D, 0});
    gemm(stream, H, D, w_in + 10752, INC, M, D, D, EGateA{out, D, 0});
    gemm(stream, H, D, w_in + 11776, INC, M, D, D, EGateB{out, T3, D, 0});
    gemm(stream, out, D, w_o, D, M, D, D, EResid{x, mod + 2 * D, T3});
    k_norm<<<M, 256, 0, stream>>>(T3, norm2_g, mod + 3 * D, mod + 4 * D, H);
    for (int j = 0; j < 4; ++j) {
        gemm(stream, H, D, w_ff1 + j * 1024, FF, M, 1024, D, EReluSq{T1, 1024, 0});
        gemm(stream, T1, 1024, w_ff2 + (size_t)j * 1024 * D, D, M, D, 1024, EFfn2{out, T3, mod + 5 * D, j == 0 ? 0 : (j == 3 ? 2 : 1), 0});
    }
    k_norm<<<M, 256, 0, stream>>>(out, norm_f_g, nullptr, nullptr, out);
}
```

```cpp
#include <hip/hip_runtime.h>
#include <hip/hip_cooperative_groups.h>
#include <cstdio>
#include <cstdint>
namespace cg = cooperative_groups;
namespace pg8 {
#define PG8_LAS __attribute__((address_space(3)))
typedef unsigned short bf16_t;
typedef short bf16x8 __attribute__((ext_vector_type(8)));
typedef float f32x4 __attribute__((ext_vector_type(4)));
typedef unsigned u32x4 __attribute__((ext_vector_type(4)));
constexpr int BM = 256, BK = 64, HALF = 128, HTB = HALF * BK * 2  , STAGE_BYTES = 8 * HTB, NXCD = 8, WGM = 8;

__host__ __device__ __forceinline__ int lds_byte(int r, int c) { const int st = (r >> 4) * 2 + (c >> 5), rr = r & 15, cc = c & 31, ob = rr * 64 + cc * 2; return st * 1024 + (ob ^ (((ob >> 9) & 1) << 5)); }
__host__ __device__ __forceinline__ void stage_rc(int b, int& R, int& C) { const int st = b / 1024, sb = b % 1024, swz = sb ^ (((sb >> 9) & 1) << 5); R = (st >> 1) * 16 + swz / 64; C = (st & 1) * 32 + (swz % 64) / 2; }
__host__ __device__ __forceinline__ int perm32(int rho) { const int n = rho >> 4, i = rho & 15; return 8 * (i >> 2) + 4 * n + (i & 3); }

struct Unit { int pm, pn; };
struct Gemm { const bf16_t* A; const bf16_t* Bt; int M, N, K; };

struct StaticOrder {
    int nM, nN, nwg, G, c;
    __host__ __device__ void init(int M, int N, int G_, int c_) { nM = M / BM; nN = N / BM; nwg = nM * nN; G = G_; c = c_; }
    __host__ __device__ bool next(int i, Unit& u) const {
        const long L = (long)i * G + c; if (L >= nwg) return false;
        int wgid = (int)L; { const int q = nwg / NXCD, r = nwg % NXCD, xcd = wgid % NXCD, off = wgid / NXCD; wgid = (xcd < r ? xcd * (q + 1) : r * (q + 1) + (xcd - r) * q) + off; }
        const int nig = WGM * nN, gid = wgid / nig, fm = gid * WGM, gsz = (nM - fm) < WGM ? (nM - fm) : WGM;
        u.pm = fm + ((wgid % nig) % gsz); u.pn = (wgid % nig) / gsz; return true;
    }
    __device__ __forceinline__ void a_ready(const Unit&) const {}
    __device__ __forceinline__ void done(const Unit&) const {}
};

typedef float f32x2_t __attribute__((ext_vector_type(2))); typedef __bf16 bf16x2_t __attribute__((ext_vector_type(2)));
__device__ __forceinline__ unsigned cvt_pk_bf16(float lo, float hi) { f32x2_t v = {lo, hi}; bf16x2_t b = __builtin_convertvector(v, bf16x2_t); return __builtin_bit_cast(unsigned, b); }
__device__ __forceinline__ void st8(bf16_t* p, f32x4 a, f32x4 b) { u32x4 w; w.x = cvt_pk_bf16(a[0], a[1]); w.y = cvt_pk_bf16(a[2], a[3]); w.z = cvt_pk_bf16(b[0], b[1]); w.w = cvt_pk_bf16(b[2], b[3]); *(u32x4*)p = w; }
__device__ __forceinline__ float bfl(unsigned w) { return __uint_as_float(w << 16); }
__device__ __forceinline__ float bfh(unsigned w) { return __uint_as_float(w & 0xffff0000u); }
__device__ __forceinline__ void ld8(const bf16_t* p, f32x4& a, f32x4& b) { const u32x4 w = *(const u32x4*)p; a = (f32x4){bfl(w.x), bfh(w.x), bfl(w.y), bfh(w.y)}; b = (f32x4){bfl(w.z), bfh(w.z), bfl(w.w), bfh(w.w)}; }
__device__ __forceinline__ f32x4 sigmoid4(f32x4 v) { f32x4 o;
#pragma unroll
    for (int j = 0; j < 4; ++j) o[j] = __builtin_amdgcn_rcpf(1.f + __builtin_amdgcn_exp2f(-1.4426950408889634f * v[j])); return o; }

constexpr float QSCALE = 0.08838834764831845f * 1.4426950408889634f;
constexpr size_t MiB_ = 1u << 20;

template <int PASS> struct EpiProj {
    static constexpr bool PERM = true, AFTER_DRAIN = false;
    bf16_t* d0; bf16_t* d1; bf16_t* d2; bf16_t* d3; const float* rope;
    __device__ __forceinline__ void operator()(const f32x4 (&acc)[2][2][4][2], const Unit& u, int wr, int wc, int fr, int fq) const {
        const int row0 = u.pm * BM + wr * 64 + fr, cl0 = wc * 32 + 8 * fq, pn = u.pn;
        if (PASS == 0) {
            const int part = pn >> 1; bf16_t* base = d0 + (size_t)part * (8 * MiB_) + (pn & 1) * 256 + cl0;
            const float sc = (part % 3 == 0) ? QSCALE : 1.0f;
#pragma unroll
            for (int ai = 0; ai < 2; ++ai)
#pragma unroll
                for (int m = 0; m < 4; ++m) { bf16_t* rp = base + (size_t)(row0 + ai * HALF + m * 16) * 512;
#pragma unroll
                    for (int bj = 0; bj < 2; ++bj) st8(rp + bj * HALF, acc[ai][bj][m][0] * sc, acc[ai][bj][m][1] * sc); }
        } else if (PASS == 1) {
            if (pn < 8) {
                const int head = pn & 3; const bool isk = pn >= 4; bf16_t* base = (isk ? d1 : d0) + head * 256 + cl0;
                const float lg = __builtin_log2f(1.0f - __builtin_amdgcn_exp2f(-5.0f - (float)head));
#pragma unroll
                for (int ai = 0; ai < 2; ++ai)
#pragma unroll
                    for (int m = 0; m < 4; ++m) { const int row = row0 + ai * HALF + m * 16, pos = row & 2047, ci = pos & 127;
                        const float e = (float)(ci + 1) * lg; const float sc = isk ? 0.0625f * __builtin_amdgcn_exp2f(-e) : __builtin_amdgcn_exp2f(e);
                        const f32x4* rp = (const f32x4*)(rope + ((size_t)pos * 128 + cl0) * 2);
                        f32x4 o1[2], o2[2];
#pragma unroll
                        for (int n = 0; n < 2; ++n) { const f32x4 ra = rp[2 * n], rb = rp[2 * n + 1]; const f32x4 x1 = acc[ai][0][m][n], x2 = acc[ai][1][m][n];
                            const f32x4 cs = (f32x4){ra[0], ra[2], rb[0], rb[2]}, sn = (f32x4){ra[1], ra[3], rb[1], rb[3]};
                            o1[n] = (x1 * cs - x2 * sn) * sc; o2[n] = (x1 * sn + x2 * cs) * sc; }
                        bf16_t* dp = base + (size_t)row * 1024; st8(dp, o1[0], o1[1]); st8(dp + HALF, o2[0], o2[1]); }
            } else {
                const bool isg = pn >= 16; bf16_t* base = (isg ? d3 : d2) + ((pn - 8) & 7) * 256 + cl0;
#pragma unroll
                for (int ai = 0; ai < 2; ++ai)
#pragma unroll
                    for (int m = 0; m < 4; ++m) { bf16_t* rp = base + (size_t)(row0 + ai * HALF + m * 16) * 2048;
#pragma unroll
                        for (int bj = 0; bj < 2; ++bj) { f32x4 a = acc[ai][bj][m][0], b = acc[ai][bj][m][1];
                            if (isg) { a = a * sigmoid4(a); b = b * sigmoid4(b); }
                            st8(rp + bj * HALF, a, b); } }
            }
        } else {
            bf16_t* base = (pn >= 4 ? d1 : d0) + (pn & 3) * 256 + cl0;
#pragma unroll
            for (int ai = 0; ai < 2; ++ai)
#pragma unroll
                for (int m = 0; m < 4; ++m) { bf16_t* rp = base + (size_t)(row0 + ai * HALF + m * 16) * 1024;
#pragma unroll
                    for (int bj = 0; bj < 2; ++bj) { f32x4 a = acc[ai][bj][m][0], b = acc[ai][bj][m][1];
                        if (PASS == 2) { a = sigmoid4(a); b = sigmoid4(b); }
                        if (PASS == 4) {
#pragma unroll
                            for (int j = 0; j < 4; ++j) { a[j] = 1.0f / (1.0f + __expf(-a[j])); b[j] = 1.0f / (1.0f + __expf(-b[j])); } }
                        st8(rp + bj * HALF, a, b); } }
        }
    }
};
struct GateOrder { Unit base;
    __device__ bool next(int i, Unit& u) const { if (i >= 2) return false; u.pm = base.pm; u.pn = base.pn + 4 * i; return true; }
    __device__ __forceinline__ void a_ready(const Unit&) const {}
    __device__ __forceinline__ void done(const Unit&) const {} };
struct EpiT3 { static constexpr bool PERM = true, AFTER_DRAIN = false; const bf16_t* sb; bf16_t* t3;
    __device__ __forceinline__ void operator()(const f32x4 (&acc)[2][2][4][2], const Unit& u, int wr, int wc, int fr, int fq) const {
        const int row0 = u.pm * BM + wr * 64 + fr, col0 = u.pn * BM + wc * 32 + 8 * fq;
#pragma unroll
        for (int ai = 0; ai < 2; ++ai)
#pragma unroll
            for (int m = 0; m < 4; ++m) { const size_t off = (size_t)(row0 + ai * HALF + m * 16) * 1024 + col0;
#pragma unroll
                for (int bj = 0; bj < 2; ++bj) { f32x4 ga, gb; ld8(sb + off + bj * HALF, ga, gb); st8(t3 + off + bj * HALF, acc[ai][bj][m][0] * ga, acc[ai][bj][m][1] * gb); } }
    } };
struct EpiMerged { static constexpr bool PERM = true, AFTER_DRAIN = false; const bf16_t* sa; const bf16_t* t3; bf16_t* mg;
    __device__ __forceinline__ void operator()(const f32x4 (&acc)[2][2][4][2], const Unit& u, int wr, int wc, int fr, int fq) const {
        const int row0 = u.pm * BM + wr * 64 + fr, col0 = u.pn * BM + wc * 32 + 8 * fq;
#pragma unroll
        for (int ai = 0; ai < 2; ++ai)
#pragma unroll
            for (int m = 0; m < 4; ++m) { const size_t off = (size_t)(row0 + ai * HALF + m * 16) * 1024 + col0;
#pragma unroll
                for (int bj = 0; bj < 2; ++bj) { f32x4 ga, gb, ta, tb; ld8(sa + off + bj * HALF, ga, gb); ld8(t3 + off + bj * HALF, ta, tb);
                    st8(mg + off + bj * HALF, acc[ai][bj][m][0] * ga + ta, acc[ai][bj][m][1] * gb + tb); } }
    } };
struct EpiX1 { static constexpr bool PERM = true, AFTER_DRAIN = false; const float* x; const float* modf; const float* n2g; float* x1; bf16_t* a5; float* rowp;
    __device__ __forceinline__ void operator()(const f32x4 (&acc)[2][2][4][2], const Unit& u, int wr, int wc, int fr, int fq) const {
        const int row0 = u.pm * BM + wr * 64 + fr, col0 = u.pn * BM + wc * 32 + 8 * fq, b = (u.pm * BM) >> 11;
        f32x4 g1[2][2], gg[2][2];
#pragma unroll
        for (int bj = 0; bj < 2; ++bj)
#pragma unroll
            for (int n = 0; n < 2; ++n) { const int c = col0 + bj * HALF + 4 * n; g1[bj][n] = *(const f32x4*)(modf + b * 6144 + 2 * 1024 + c);
                gg[bj][n] = *(const f32x4*)(n2g + c) * (*(const f32x4*)(modf + b * 6144 + 4 * 1024 + c) + 1.0f); }
#pragma unroll
        for (int ai = 0; ai < 2; ++ai)
#pragma unroll
            for (int m = 0; m < 4; ++m) { const int row = row0 + ai * HALF + m * 16; const size_t off = (size_t)row * 1024 + col0; float ss = 0.f;
#pragma unroll
                for (int bj = 0; bj < 2; ++bj) { f32x4 v[2];
#pragma unroll
                    for (int n = 0; n < 2; ++n) { v[n] = *(const f32x4*)(x + off + bj * HALF + 4 * n) + g1[bj][n] * acc[ai][bj][m][n]; *(f32x4*)(x1 + off + bj * HALF + 4 * n) = v[n];
                        ss += (v[n][0] * v[n][0] + v[n][1] * v[n][1]) + (v[n][2] * v[n][2] + v[n][3] * v[n][3]); }
                    st8(a5 + off + bj * HALF, v[0] * gg[bj][0], v[1] * gg[bj][1]); }
                ss += __shfl_xor(ss, 16); ss += __shfl_xor(ss, 32);
                if (fq == 0) rowp[(size_t)row * 16 + u.pn * 4 + wc] = ss; }
    } };
struct EpiFF1 { static constexpr bool PERM = true, AFTER_DRAIN = false; const float* rowp; const float* bias5; bf16_t* uo;
    __device__ __forceinline__ void operator()(const f32x4 (&acc)[2][2][4][2], const Unit& u, int wr, int wc, int fr, int fq) const {
        const int row0 = u.pm * BM + wr * 64 + fr, col0 = u.pn * BM + wc * 32 + 8 * fq, b = (u.pm * BM) >> 11;
        f32x4 bs[2][2];
#pragma unroll
        for (int bj = 0; bj < 2; ++bj)
#pragma unroll
            for (int n = 0; n < 2; ++n) bs[bj][n] = *(const f32x4*)(bias5 + b * 4096 + col0 + bj * HALF + 4 * n);
#pragma unroll
        for (int ai = 0; ai < 2; ++ai)
#pragma unroll
            for (int m = 0; m < 4; ++m) { const int row = row0 + ai * HALF + m * 16; const f32x4* rp = (const f32x4*)(rowp + (size_t)row * 16);
                const f32x4 s4 = (rp[0] + rp[1]) + (rp[2] + rp[3]); const float rstd = __builtin_amdgcn_rsqf(((s4[0] + s4[1]) + (s4[2] + s4[3])) * (1.0f / 1024.0f) + 1e-6f);
#pragma unroll
                for (int bj = 0; bj < 2; ++bj) { f32x4 v[2];
#pragma unroll
                    for (int n = 0; n < 2; ++n) { v[n] = acc[ai][bj][m][n] * rstd + bs[bj][n];
#pragma unroll
                        for (int j = 0; j < 4; ++j) { const float r = v[n][j] > 0.f ? v[n][j] : 0.f; v[n][j] = r * r; } }
                    st8(uo + (size_t)row * 4096 + col0 + bj * HALF, v[0], v[1]); } }
    } };
struct EpiX2 { static constexpr bool PERM = true, AFTER_DRAIN = false; const float* modf; float* x1; float* rowp;
    __device__ __forceinline__ void operator()(const f32x4 (&acc)[2][2][4][2], const Unit& u, int wr, int wc, int fr, int fq) const {
        const int row0 = u.pm * BM + wr * 64 + fr, col0 = u.pn * BM + wc * 32 + 8 * fq, b = (u.pm * BM) >> 11;
        f32x4 g2[2][2];
#pragma unroll
        for (int bj = 0; bj < 2; ++bj)
#pragma unroll
            for (int n = 0; n < 2; ++n) g2[bj][n] = *(const f32x4*)(modf + b * 6144 + 5 * 1024 + col0 + bj * HALF + 4 * n);
#pragma unroll
        for (int ai = 0; ai < 2; ++ai)
#pragma unroll
            for (int m = 0; m < 4; ++m) { const int row = row0 + ai * HALF + m * 16; const size_t off = (size_t)row * 1024 + col0; float ss = 0.f;
#pragma unroll
                for (int bj = 0; bj < 2; ++bj)
#pragma unroll
                    for (int n = 0; n < 2; ++n) { float* p = x1 + off + bj * HALF + 4 * n; const f32x4 v = *(const f32x4*)p + g2[bj][n] * acc[ai][bj][m][n]; *(f32x4*)p = v;
                        ss += (v[0] * v[0] + v[1] * v[1]) + (v[2] * v[2] + v[3] * v[3]); }
                ss += __shfl_xor(ss, 16); ss += __shfl_xor(ss, 32);
                if (fq == 0) rowp[(size_t)row * 16 + u.pn * 4 + wc] = ss; }
    } };
template <class Epi, class Sched, bool ALIGN_EPI = false, bool SP2 = false>
__device__ __forceinline__ void gemm_phase(PG8_LAS unsigned char* lds, const Gemm g, const Sched& S, const Epi& E) {
    const int tid = threadIdx.x, wid = __builtin_amdgcn_readfirstlane(tid >> 6), lane = tid & 63, wr = wid >> 2, wc = wid & 3, fr = lane & 15, fq = lane >> 4;
    const int K = g.K, nt = K / BK;
    unsigned voffA[2], voffB[2];
#pragma unroll
    for (int i = 0; i < 2; ++i) { int R, C; stage_rc(tid * 16 + i * 8192, R, C); const int Rb = Epi::PERM ? ((R & ~31) + perm32(R & 31)) : R;
        voffA[i] = (unsigned)(R * K + C) * 2u; voffB[i] = (unsigned)(Rb * K + C) * 2u; }
    const size_t kstep = (size_t)(BK * 2);
    const size_t hstep = (size_t)HALF * K * 2;
    const size_t tstep = 2 * hstep;
    const unsigned ldsw = (unsigned)wid * 1024u;
    const int aoff = lds_byte(wr * 64 + fr, fq * 8), boff = lds_byte(wc * 32 + fr, fq * 8);
#define PG8_SA(b, h) (((b) * 2 + (h)) * HTB)
#define PG8_SB(b, h) ((4 + (b) * 2 + (h)) * HTB)
#define PG8_STAGE(bufoff, gbase, voff) do { _Pragma("unroll") for (int _i = 0; _i < 2; ++_i) \
        __builtin_amdgcn_global_load_lds((const unsigned*)((const char*)(gbase) + (voff)[_i]), (PG8_LAS unsigned*)(lds + (bufoff) + ldsw + _i * 8192), 16, 0, 0); } while (0)
#define PG8_LDA(dst, b, h) do { _Pragma("unroll") for (int m = 0; m < 4; ++m) _Pragma("unroll") for (int k = 0; k < 2; ++k) dst[m][k] = *(const PG8_LAS bf16x8*)(lds + PG8_SA(b, h) + aoff + m * 2048 + k * 1024); } while (0)
#define PG8_LDB(dst, b, h) do { _Pragma("unroll") for (int n = 0; n < 2; ++n) _Pragma("unroll") for (int k = 0; k < 2; ++k) dst[n][k] = *(const PG8_LAS bf16x8*)(lds + PG8_SB(b, h) + boff + n * 2048 + k * 1024); } while (0)
#define PG8_MMA(ai, bj, At, Bt) do { __builtin_amdgcn_s_setprio(1); _Pragma("unroll") for (int m = 0; m < 4; ++m) _Pragma("unroll") for (int n = 0; n < 2; ++n) _Pragma("unroll") for (int k = 0; k < 2; ++k) \
        acc[ai][bj][m][n] = __builtin_amdgcn_mfma_f32_16x16x32_bf16(Bt[n][k], At[m][k], acc[ai][bj][m][n], 0, 0, 0); __builtin_amdgcn_s_setprio(0); } while (0)
#define PG8_WAIT_V(n) asm volatile("s_waitcnt vmcnt(" #n ")" ::: "memory")
#define PG8_WAIT_L(n) asm volatile("s_waitcnt lgkmcnt(" #n ")" ::: "memory")
#define PG8_BAR __builtin_amdgcn_s_barrier()
#define PG8_SCHED __builtin_amdgcn_sched_barrier(0)
    Unit cur, nxt; int ui = 0;
    if (!S.next(0, cur)) return;
    f32x4 acc[2][2][4][2];
#pragma unroll
    for (int a = 0; a < 2; ++a)
#pragma unroll
        for (int b = 0; b < 2; ++b)
#pragma unroll
            for (int m = 0; m < 4; ++m)
#pragma unroll
                for (int n = 0; n < 2; ++n) acc[a][b][m][n] = (f32x4){0.f, 0.f, 0.f, 0.f};
    bf16x8 At[4][2], B0[2][2], B1[2][2];
    const char* cA = (const char*)g.A + (size_t)cur.pm * tstep; const char* cB = (const char*)g.Bt + (size_t)cur.pn * tstep;
    S.a_ready(cur);
    if constexpr (SP2) {
        PG8_STAGE(PG8_SB(0, 0), cB, voffB); PG8_STAGE(PG8_SB(0, 1), cB + hstep, voffB); PG8_STAGE(PG8_SA(0, 0), cA, voffA); PG8_STAGE(PG8_SA(0, 1), cA + hstep, voffA);
        if (wr == 1) PG8_BAR;
        PG8_WAIT_V(2); PG8_BAR;
        PG8_STAGE(PG8_SB(1, 0), cB + kstep, voffB); PG8_STAGE(PG8_SA(1, 0), cA + kstep, voffA); PG8_STAGE(PG8_SB(1, 1), cB + hstep + kstep, voffB);
        PG8_WAIT_V(6); PG8_BAR;
    } else {
        PG8_STAGE(PG8_SB(0, 0), cB, voffB); PG8_STAGE(PG8_SA(0, 0), cA, voffA); PG8_STAGE(PG8_SB(0, 1), cB + hstep, voffB); PG8_STAGE(PG8_SA(0, 1), cA + hstep, voffA);
        if (wr == 1) PG8_BAR;
        PG8_WAIT_V(4); PG8_BAR;
        PG8_STAGE(PG8_SB(1, 0), cB + kstep, voffB); PG8_STAGE(PG8_SA(1, 0), cA + kstep, voffA); PG8_STAGE(PG8_SB(1, 1), cB + hstep + kstep, voffB);
        PG8_WAIT_V(6); PG8_BAR;
    }
    for (;;) {
        const bool has_next = S.next(ui + 1, nxt);
        const char* nA = has_next ? (const char*)g.A + (size_t)nxt.pm * tstep : cA; const char* nB = has_next ? (const char*)g.Bt + (size_t)nxt.pn * tstep : cB;
        for (int t = 0; t < nt; t += 2) {
            const bool last = (t == nt - 2);
            const char* a1 = cA + (size_t)(t + 1) * kstep;
            const char* a2 = last ? nA : cA + (size_t)(t + 2) * kstep; const char* b2 = last ? nB : cB + (size_t)(t + 2) * kstep;
            const char* a3 = a2 + kstep; const char* b3 = b2 + kstep;
            if (last && has_next) S.a_ready(nxt);
            if constexpr (SP2) {
            PG8_LDB(B0, 0, 0); PG8_LDB(B1, 0, 1); PG8_SCHED; PG8_LDA(At, 0, 0); PG8_STAGE(PG8_SA(1, 1), a1 + hstep, voffA);
            PG8_WAIT_V(8); PG8_WAIT_L(0); PG8_BAR; PG8_MMA(0, 0, At, B0); PG8_MMA(0, 1, At, B1); PG8_BAR; PG8_SCHED;
            PG8_LDA(At, 0, 1); PG8_STAGE(PG8_SB(0, 0), b2, voffB); PG8_STAGE(PG8_SB(0, 1), b2 + hstep, voffB); PG8_STAGE(PG8_SA(0, 0), a2, voffA);
            PG8_WAIT_V(8); PG8_WAIT_L(0); PG8_BAR; PG8_MMA(1, 0, At, B0); PG8_MMA(1, 1, At, B1); PG8_BAR; PG8_SCHED;
            PG8_LDB(B0, 1, 0); PG8_LDB(B1, 1, 1); PG8_SCHED; PG8_LDA(At, 1, 0); PG8_STAGE(PG8_SA(0, 1), a2 + hstep, voffA);
            PG8_WAIT_V(8); PG8_WAIT_L(0); PG8_BAR; PG8_MMA(0, 0, At, B0); PG8_MMA(0, 1, At, B1); PG8_BAR; PG8_SCHED;
            PG8_LDA(At, 1, 1); PG8_STAGE(PG8_SB(1, 0), b3, voffB); PG8_STAGE(PG8_SB(1, 1), b3 + hstep, voffB); PG8_STAGE(PG8_SA(1, 0), a3, voffA);
            PG8_WAIT_V(8); PG8_WAIT_L(0); PG8_BAR; PG8_MMA(1, 0, At, B0); PG8_MMA(1, 1, At, B1); PG8_BAR; PG8_SCHED;
            } else {
            PG8_LDB(B0, 0, 0); PG8_SCHED; PG8_LDA(At, 0, 0); PG8_STAGE(PG8_SA(1, 1), a1 + hstep, voffA);
            PG8_WAIT_L(8); PG8_BAR; PG8_WAIT_L(0); PG8_MMA(0, 0, At, B0); PG8_BAR; PG8_SCHED;
            PG8_LDB(B1, 0, 1); PG8_STAGE(PG8_SB(0, 0), b2, voffB);
            PG8_BAR; PG8_WAIT_L(0); PG8_MMA(0, 1, At, B1); PG8_BAR;
            PG8_LDA(At, 0, 1); PG8_STAGE(PG8_SA(0, 0), a2, voffA);
            PG8_BAR; PG8_WAIT_L(0); PG8_MMA(1, 0, At, B0); PG8_BAR; PG8_SCHED;
            PG8_STAGE(PG8_SB(0, 1), b2 + hstep, voffB);
            PG8_WAIT_V(6); PG8_BAR; PG8_MMA(1, 1, At, B1); PG8_BAR;
            PG8_LDB(B0, 1, 0); PG8_SCHED; PG8_LDA(At, 1, 0); PG8_STAGE(PG8_SA(0, 1), a2 + hstep, voffA);
            PG8_WAIT_L(8); PG8_BAR; PG8_WAIT_L(0); PG8_MMA(0, 0, At, B0); PG8_BAR; PG8_SCHED;
            PG8_LDB(B1, 1, 1); PG8_STAGE(PG8_SB(1, 0), b3, voffB);
            PG8_BAR; PG8_WAIT_L(0); PG8_MMA(0, 1, At, B1); PG8_BAR;
            PG8_LDA(At, 1, 1); PG8_STAGE(PG8_SA(1, 0), a3, voffA);
            PG8_BAR; PG8_WAIT_L(0); PG8_MMA(1, 0, At, B0); PG8_BAR; PG8_SCHED;
            PG8_STAGE(PG8_SB(1, 1), b3 + hstep, voffB);
            PG8_WAIT_V(6); PG8_BAR; PG8_MMA(1, 1, At, B1); PG8_BAR;
            }
        }
        if constexpr (ALIGN_EPI) { if (wr == 0) PG8_BAR; }
        if constexpr (!Epi::AFTER_DRAIN) { E(acc, cur, wr, wc, fr, fq); S.done(cur); }
        if (!has_next) break;
#pragma unroll
        for (int a = 0; a < 2; ++a)
#pragma unroll
            for (int b = 0; b < 2; ++b)
#pragma unroll
                for (int m = 0; m < 4; ++m)
#pragma unroll
                    for (int n = 0; n < 2; ++n) acc[a][b][m][n] = (f32x4){0.f, 0.f, 0.f, 0.f};
        cur = nxt; cA = nA; cB = nB; ++ui;
        if constexpr (ALIGN_EPI) { if (wr == 1) PG8_BAR; }
    }
    PG8_WAIT_V(0);
    if constexpr (!ALIGN_EPI) { if (wr == 0) PG8_BAR; }
    PG8_BAR;
    if constexpr (Epi::AFTER_DRAIN) { E.fused(acc, cur, wr, wc, fr, fq, lds, wid, lane); S.done(cur); }
#undef PG8_SA
#undef PG8_SB
#undef PG8_STAGE
#undef PG8_LDA
#undef PG8_LDB
#undef PG8_MMA
#undef PG8_WAIT_V
#undef PG8_WAIT_L
#undef PG8_BAR
#undef PG8_SCHED
}
}
#define GAS __attribute__((address_space(1)))
#define LAS __attribute__((address_space(3)))
typedef unsigned short bf16;
typedef unsigned v4u __attribute__((ext_vector_type(4)));
typedef float f32x4 __attribute__((ext_vector_type(4)));
typedef short bf16x8 __attribute__((ext_vector_type(8)));
typedef GAS unsigned gu32;
typedef GAS unsigned long long gu64;
#define RLX_AGENT __ATOMIC_RELAXED, __HIP_MEMORY_SCOPE_AGENT
#define LDS_WAIT() asm volatile("s_waitcnt lgkmcnt(0)" ::: "memory")
#define VM_WAIT() asm volatile("s_waitcnt vmcnt(0)" ::: "memory")
__device__ __forceinline__ unsigned long long rt() { return __builtin_amdgcn_s_memrealtime(); }
__device__ __forceinline__ unsigned f2bf(float f) { unsigned u = __builtin_bit_cast(unsigned, f); return (u + 0x7fffu + ((u >> 16) & 1u)) >> 16; }
__device__ __forceinline__ unsigned pk2(float lo, float hi) { return f2bf(lo) | (f2bf(hi) << 16); }

#define XB_TMO      128
#define XB_XCNT(j)  (256  + 64 * (j))
#define XB_XSUB(j)  (1280 + 64 * (j))
#define XB_XGEN(j)  (2304 + 64 * (j))
#define XB_TOP      3328
#define XB_TOPGEN   3392
#define XCD_BAR_WORDS 3456
#define XB_SPIN_CAP (1u << 18)

__device__ __forceinline__ unsigned xb_ld(unsigned* p)              { return __hip_atomic_load(p, __ATOMIC_RELAXED, __HIP_MEMORY_SCOPE_AGENT); }
__device__ __forceinline__ unsigned xb_add(unsigned* p, unsigned v) { return __hip_atomic_fetch_add(p, v, __ATOMIC_RELAXED, __HIP_MEMORY_SCOPE_AGENT); }
__device__ __forceinline__ unsigned xb_xcc_id() { return (unsigned)__builtin_amdgcn_s_getreg((3 << 11) | 20) & 0xFu; }
#define XB_SPIN(cond, bar) do { unsigned _sp = 0; while (cond) { __builtin_amdgcn_s_sleep(1); \
    if ((++_sp & 255u) == 0u) { if (xb_ld(&(bar)[XB_TMO])) break; if (_sp > XB_SPIN_CAP) { atomicAdd(&(bar)[XB_TMO], 1u); break; } } } } while (0)

struct XcdBarrier {
    unsigned* bar; unsigned x;
    volatile LAS unsigned* st;
};

__device__ __forceinline__ XcdBarrier xcd_barrier_post(unsigned* bar, volatile LAS unsigned* st) {
    XcdBarrier b; b.bar = bar; b.x = xb_xcc_id(); b.st = st;
    if (threadIdx.x == 0) (void)xb_add(&bar[XB_XCNT(b.x)], 1u);
    return b;
}
__device__ __forceinline__ void xcd_barrier_complete(unsigned* bar, unsigned x, unsigned& nloc, unsigned& nx) {
    const unsigned G = gridDim.x * gridDim.y * gridDim.z;
    unsigned sum, cnt, mine, sp = 0u;
    for (;;) {
        sum = 0u; cnt = 0u; mine = 0u;
#pragma unroll
        for (unsigned j = 0; j < 16; ++j) { const unsigned c = xb_ld(&bar[XB_XCNT(j)]); sum += c; cnt += (c > 0u) ? 1u : 0u; mine = (j == x) ? c : mine; }
        if (sum == G) break;
        __builtin_amdgcn_s_sleep(1);
        if ((++sp & 255u) == 0u) { if (xb_ld(&bar[XB_TMO])) break; if (sp > XB_SPIN_CAP) { atomicAdd(&bar[XB_TMO], 1u); break; } }
    }
    nloc = mine > 0u ? mine : 1u; nx = cnt > 0u ? cnt : 1u;
}

__device__ __forceinline__ void xcd_barrier(const XcdBarrier& b) {
    asm volatile("s_waitcnt vmcnt(0)" ::: "memory");
    __syncthreads();
    if (threadIdx.x == 0) {
        unsigned* bar = b.bar;
        __builtin_amdgcn_s_waitcnt(0);
        unsigned nloc = b.st[0], nx = b.st[1];
        if (nloc == 0u) { xcd_barrier_complete(bar, b.x, nloc, nx); b.st[0] = nloc; b.st[1] = nx; }
        const unsigned old = xb_add(&bar[XB_XSUB(b.x)], 1u);
        const unsigned gen = old / nloc;
        if (old + 1u == (gen + 1u) * nloc) {
            __builtin_amdgcn_fence(__ATOMIC_RELEASE, "agent");
            asm volatile("s_waitcnt vmcnt(0)" ::: "memory");
            const unsigned og = xb_add(&bar[XB_TOP], 1u);
            const unsigned tg = og / nx;
            if (og + 1u == (tg + 1u) * nx) xb_add(&bar[XB_TOPGEN], 1u);
            else XB_SPIN(xb_ld(&bar[XB_TOPGEN]) == tg, bar);
            __builtin_amdgcn_fence(__ATOMIC_ACQUIRE, "agent");
            xb_add(&bar[XB_XGEN(b.x)], 1u);
            asm volatile("s_waitcnt vmcnt(0)" ::: "memory");
        } else {
            XB_SPIN(xb_ld(&bar[XB_XGEN(b.x)]) == gen, bar);
            __builtin_amdgcn_fence(__ATOMIC_ACQUIRE, "agent");
            asm volatile("s_waitcnt vmcnt(0)" ::: "memory");
        }
    }
    __syncthreads();
}
constexpr int DM = 1024, NBATCH = 8, SEQ = 2048, MTOK = NBATCH * SEQ, INC = 12800, DFF = 4096;
constexpr int NWAVES = 8;
constexpr float LOG2E = 1.4426950408889634f;
constexpr size_t MiB = 1u << 20;
constexpr size_t WS_CTL = 0, CTL_ZERO_BYTES = 64 * 1024;
constexpr size_t WS_PART = 1 * MiB;
constexpr size_t WS_ROWP = 1 * MiB, WS_ROWP2 = 2 * MiB;
constexpr size_t WS_MODF = 4 * MiB, WS_BIAS5 = 4 * MiB + 256 * 1024, WS_ABIAS = 4 * MiB + 512 * 1024, WS_ROPE = 5 * MiB;
constexpr size_t WS_WIN = 8 * MiB, WS_WRET = 33 * MiB, WS_WATT = 37 * MiB, WS_WO = 38 * MiB, WS_WFF1 = 40 * MiB, WS_WFF2 = 48 * MiB;
constexpr size_t WS_HB = 56 * MiB;
constexpr size_t WS_R = 88 * MiB;
constexpr size_t WS_ATT = 232 * MiB, WS_GNS = 248 * MiB, WS_END = 256 * MiB;
constexpr size_t DO_LSE = 48 * MiB;
constexpr int CW_BAR = 4096;
constexpr int RING_BYTES = 131072, MISC_OFF = 147456, LDS_BYTES = 151552;

#define GRID_WAVES(F) const int gw = (F).vcu * NWAVES + (F).wave, NGW = (F).G * NWAVES
struct Frame { LAS unsigned char* lds; int tid, lane, wave, vcu, G; };
struct Args { const float* in[16]; float* out; unsigned char* ws; int ph_lo, ph_hi; };

__device__ __forceinline__ float wave_sum(float v) {
#pragma unroll
    for (int o = 1; o < 64; o <<= 1) v += __shfl_xor(v, o);
    return v;
}
__device__ __forceinline__ float wave_max(float v) {
#pragma unroll
    for (int o = 1; o < 64; o <<= 1) v = fmaxf(v, __shfl_xor(v, o));
    return v;
}
__device__ __forceinline__ float bf2f(bf16 h) { return __uint_as_float((unsigned)h << 16); }
__device__ __forceinline__ float bflo(unsigned w) { return __uint_as_float(w << 16); }
__device__ __forceinline__ float bfhi(unsigned w) { return __uint_as_float(w & 0xffff0000u); }
__device__ __forceinline__ int t5_bucket(int dist) {
    if (dist < 16) return dist;
    return 16 + (dist >= 22) + (dist >= 30) + (dist >= 40) + (dist >= 54) + (dist >= 73) + (dist >= 99) + (dist >= 134) + (dist >= 182) + (dist >= 246) + (dist >= 332)
         + (dist >= 450) + (dist >= 609) + (dist >= 825) + (dist >= 1117) + (dist >= 1513);
}

__device__ __forceinline__ void p0_transpose_item(const float* W, int K, int N, bf16* WT, LAS float* scr, int item, int lane) {
    const int nblk = N / 32, kb = item / nblk, nb = item % nblk, k0 = 64 * kb, n0 = 32 * nb;
#pragma unroll 8
    for (int i = 0; i < 32; ++i) { const int kk = 2 * i + (lane >> 5); scr[kk * 33 + (lane & 31)] = W[(size_t)(k0 + kk) * N + n0 + (lane & 31)]; }
    LDS_WAIT(); asm volatile("" ::: "memory");
    const int c = lane & 7;
#pragma unroll
    for (int j = 0; j < 4; ++j) { const int n = (lane >> 3) + 8 * j; const LAS float* s = scr + (8 * c) * 33 + n;
        v4u o; o.x = pk2(s[0 * 33], s[1 * 33]); o.y = pk2(s[2 * 33], s[3 * 33]); o.z = pk2(s[4 * 33], s[5 * 33]); o.w = pk2(s[6 * 33], s[7 * 33]);
        *(GAS v4u*)(WT + (size_t)(n0 + n) * K + k0 + 8 * c) = o; }
    LDS_WAIT(); asm volatile("" ::: "memory");
}
__device__ __forceinline__ void phase_p0(const Frame& F, const Args& a) {
    LAS float* scr = (LAS float*)(F.lds + F.wave * 16384);
    GRID_WAVES(F);
    unsigned char* ws = a.ws;
    constexpr int I_IN = 16 * 400, I_RET = 32 * 32, I_ATT = 8 * 32, I_O = 16 * 32, I_F1 = 16 * 128, I_F2 = 64 * 32, I_T = I_IN + I_RET + I_ATT + I_O + I_F1 + I_F2;
    constexpr int I_ADA = 96 * 16;
    for (int it = gw; it < I_T + I_ADA; it += NGW) {
        int r = it;
        if (r < I_ADA) {
            const int cgp = r % 96, ks = r / 96, n = cgp * 64 + F.lane;
            const float* c = a.in[1]; const float* w = a.in[2];
            float sv[8], acc[8];
#pragma unroll
            for (int b = 0; b < 8; ++b) { const float cv = c[b * DM + ks * 64 + F.lane]; sv[b] = cv / (1.0f + __expf(-cv)); acc[b] = 0.f; }
            for (int kk = 0; kk < 64; ++kk) { const float wv = w[(size_t)(ks * 64 + kk) * 6144 + n];
#pragma unroll
                for (int b = 0; b < 8; ++b) acc[b] = fmaf(__int_as_float(__builtin_amdgcn_readlane(__float_as_int(sv[b]), kk)), wv, acc[b]); }
            float* part = (float*)(ws + WS_PART);
#pragma unroll
            for (int b = 0; b < 8; ++b) part[(size_t)(ks * 8 + b) * 6144 + n] = acc[b];
            continue;
        }
        r -= I_ADA;
        if (r < I_IN) { p0_transpose_item(a.in[5], DM, INC, (bf16*)(ws + WS_WIN), scr, r, F.lane); continue; } r -= I_IN;
        if (r < I_RET) { p0_transpose_item(a.in[9], 2048, DM, (bf16*)(ws + WS_WRET), scr, r, F.lane); continue; } r -= I_RET;
        if (r < I_ATT) { p0_transpose_item(a.in[10], 512, DM, (bf16*)(ws + WS_WATT), scr, r, F.lane); continue; } r -= I_ATT;
        if (r < I_O) { p0_transpose_item(a.in[11], DM, DM, (bf16*)(ws + WS_WO), scr, r, F.lane); continue; } r -= I_O;
        if (r < I_F1) { p0_transpose_item(a.in[13], DM, DFF, (bf16*)(ws + WS_WFF1), scr, r, F.lane); continue; } r -= I_F1;
        p0_transpose_item(a.in[14], DFF, DM, (bf16*)(ws + WS_WFF2), scr, r, F.lane);
    }
    float2* rope = (float2*)(ws + WS_ROPE);
    for (int idx = (F.vcu * NWAVES + F.wave) * 64 + F.lane; idx < SEQ * 128; idx += F.G * NWAVES * 64) {
        const int pos = idx >> 7, i = idx & 127;
        const float inv = powf(10000.0f, -(float)i / 128.0f), ang = (float)pos * inv;
        rope[idx] = make_float2(cosf(ang), sinf(ang));
    }
    if (F.vcu == F.G - 1) {
        float* ab = (float*)(ws + WS_ABIAS); const float* rel = a.in[6];
        for (int idx = F.tid; idx < 12 * 132; idx += NWAVES * 64) { const int gh = idx / 132, m = idx % 132, g = gh >> 2;
            ab[idx] = (m <= 128) ? rel[t5_bucket(m << (2 * g)) * 12 + gh] * LOG2E : 0.f; }
    }
}
__device__ __forceinline__ void phase_p1(const Frame& F, const Args& a) {
    unsigned char* ws = a.ws; const float* part = (const float*)(ws + WS_PART); const float* b_ada = a.in[3];
    float* modf = (float*)(ws + WS_MODF);
    for (int it = F.vcu; it < 48; it += F.G) {
        const int b = it / 6, ch = it % 6;
        for (int col = F.tid; col < 1024; col += NWAVES * 64) { const int n = ch * 1024 + col; float s = b_ada[n];
#pragma unroll
            for (int ks = 0; ks < 16; ++ks) s += part[(size_t)(ks * 8 + b) * 6144 + n];
            modf[b * 6144 + n] = s; }
    }
    LAS float* sh1 = (LAS float*)F.lds; LAS float* g1c = sh1 + 1024;
    const float* x = a.in[0]; const float* n1g = a.in[4]; bf16* hb = (bf16*)(ws + WS_HB);
    for (int rb = F.vcu; rb < MTOK / 64; rb += F.G) {
        const int b = rb >> 5;
        __syncthreads();
        for (int col = F.tid; col < 1024; col += NWAVES * 64) { float s0 = b_ada[col], s1 = b_ada[1024 + col];
#pragma unroll
            for (int ks = 0; ks < 16; ++ks) { s0 += part[(size_t)(ks * 8 + b) * 6144 + col]; s1 += part[(size_t)(ks * 8 + b) * 6144 + 1024 + col]; }
            sh1[col] = s0; g1c[col] = n1g[col] * (1.0f + s1); }
        __syncthreads();
        for (int rr = 0; rr < 8; ++rr) {
            const int row = rb * 64 + F.wave * 8 + rr;
            const GAS f32x4* xr = (const GAS f32x4*)(x + (size_t)row * DM) + F.lane;
            f32x4 v[4]; float s = 0.f;
#pragma unroll
            for (int j = 0; j < 4; ++j) { v[j] = xr[64 * j]; s += (v[j].x * v[j].x + v[j].y * v[j].y) + (v[j].z * v[j].z + v[j].w * v[j].w); }
            const float rstd = 1.0f / sqrtf(wave_sum(s) * (1.f / DM) + 1e-6f);
            GAS unsigned long long* o8 = (GAS unsigned long long*)(hb + (size_t)row * DM) + F.lane;
#pragma unroll
            for (int j = 0; j < 4; ++j) { const int c = 4 * F.lane + 256 * j; const f32x4 g = *(const LAS f32x4*)(g1c + c), sf = *(const LAS f32x4*)(sh1 + c);
                const f32x4 o = v[j] * rstd * g + sf;
                o8[64 * j] = (unsigned long long)pk2(o.x, o.y) | ((unsigned long long)pk2(o.z, o.w) << 32); }
        }
    }
    __syncthreads();
}
__device__ __forceinline__ void phase_attn_naive(const Frame& F, const Args& a) {
    GRID_WAVES(F);
    LAS float* qs = (LAS float*)(F.lds + F.wave * 2048); LAS float* ps = qs + 128;
    const float* abias = (const float*)(a.ws + WS_ABIAS);
    for (int item = gw; item < MTOK * 12; item += NGW) {
        const int gh = item / MTOK, row = item % MTOK, g = gh >> 2, h = gh & 3, sh = 2 * g, dil = 1 << sh, tq = row & 2047, p = tq >> sh;
        const bf16* Q = (const bf16*)(a.ws + WS_R + (size_t)(3 * g + 0) * 16 * MiB); const bf16* K = (const bf16*)(a.ws + WS_R + (size_t)(3 * g + 1) * 16 * MiB); const bf16* V = (const bf16*)(a.ws + WS_R + (size_t)(3 * g + 2) * 16 * MiB);
        const unsigned qw = *(const unsigned*)(Q + (size_t)row * 512 + h * 128 + 2 * F.lane);
        qs[2 * F.lane] = bflo(qw); qs[2 * F.lane + 1] = bfhi(qw);
        LDS_WAIT(); asm volatile("" ::: "memory");
        float sc[3];
#pragma unroll
        for (int u = 0; u < 3; ++u) {
            const int m = F.lane + 64 * u; float s = -1e30f;
            if (m <= 128 && p - m >= 0) {
                const v4u* kr = (const v4u*)(K + (size_t)(row - m * dil) * 512 + h * 128); float acc = 0.f;
                for (int c = 0; c < 16; ++c) { const v4u w = kr[c]; const LAS float* q8 = qs + 8 * c;
                    acc += bflo(w.x) * q8[0] + bfhi(w.x) * q8[1] + bflo(w.y) * q8[2] + bfhi(w.y) * q8[3] + bflo(w.z) * q8[4] + bfhi(w.z) * q8[5] + bflo(w.w) * q8[6] + bfhi(w.w) * q8[7]; }
                s = acc + abias[gh * 132 + m];
            }
            sc[u] = s;
        }
        const float mx = wave_max(fmaxf(sc[0], fmaxf(sc[1], sc[2])));
        float den = 0.f;
#pragma unroll
        for (int u = 0; u < 3; ++u) { const int m = F.lane + 64 * u; const float e = (sc[u] > -1e29f) ? __builtin_amdgcn_exp2f(sc[u] - mx) : 0.f; if (m < 132) ps[m] = e; den += e; }
        den = wave_sum(den);
        LDS_WAIT(); asm volatile("" ::: "memory");
        const int mmax = p < 128 ? p : 128; float a0 = 0.f, a1 = 0.f;
        for (int m = 0; m <= mmax; ++m) { const unsigned vw = *(const unsigned*)(V + (size_t)(row - m * dil) * 512 + h * 128 + 2 * F.lane); const float pv = ps[m]; a0 += pv * bflo(vw); a1 += pv * bfhi(vw); }
        const float inv = 1.0f / den;
        bf16* og = (bf16*)((unsigned char*)a.out + (size_t)g * 16 * MiB);
        *(unsigned*)(og + (size_t)row * 512 + h * 128 + 2 * F.lane) = pk2(a0 * inv, a1 * inv);
        if (F.lane == 0) ((float*)((unsigned char*)a.out + DO_LSE))[((size_t)g * MTOK + row) * 4 + h] = mx + __builtin_log2f(den);
        LDS_WAIT(); asm volatile("" ::: "memory");
    }
}
__device__ __forceinline__ void phase_merge(const Frame& F, const Args& a) {
    GRID_WAVES(F);
    const float* lse = (const float*)((unsigned char*)a.out + DO_LSE); bf16* att = (bf16*)(a.ws + WS_ATT);
    for (int row = gw; row < MTOK; row += NGW) {
        const int h = F.lane >> 4; float l[3], mx = -1e30f;
#pragma unroll
        for (int g = 0; g < 3; ++g) { l[g] = lse[((size_t)g * MTOK + row) * 4 + h]; mx = fmaxf(mx, l[g]); }
        float w[3], ws_ = 0.f;
#pragma unroll
        for (int g = 0; g < 3; ++g) { w[g] = __builtin_amdgcn_exp2f(l[g] - mx); ws_ += w[g]; }
        const float inv = 1.0f / ws_; float o[8];
#pragma unroll
        for (int j = 0; j < 8; ++j) o[j] = 0.f;
#pragma unroll
        for (int g = 0; g < 3; ++g) { const v4u v = *(const v4u*)((const bf16*)((unsigned char*)a.out + (size_t)g * 16 * MiB) + (size_t)row * 512 + F.lane * 8); const float wg = w[g] * inv;
            o[0] += wg * bflo(v.x); o[1] += wg * bfhi(v.x); o[2] += wg * bflo(v.y); o[3] += wg * bfhi(v.y); o[4] += wg * bflo(v.z); o[5] += wg * bfhi(v.z); o[6] += wg * bflo(v.w); o[7] += wg * bfhi(v.w); }
        v4u r; r.x = pk2(o[0], o[1]); r.y = pk2(o[2], o[3]); r.z = pk2(o[4], o[5]); r.w = pk2(o[6], o[7]);
        *(v4u*)(att + (size_t)row * 512 + F.lane * 8) = r;
    }
    const float* modf = (const float*)(a.ws + WS_MODF); const bf16* w1t = (const bf16*)(a.ws + WS_WFF1); float* bias5 = (float*)(a.ws + WS_BIAS5);
    for (int n = gw; n < DFF; n += NGW) {
        float wv[16];
        { const v4u w0 = *(const v4u*)(w1t + (size_t)n * DM + 16 * F.lane), w1 = *(const v4u*)(w1t + (size_t)n * DM + 16 * F.lane + 8);
          wv[0] = bflo(w0.x); wv[1] = bfhi(w0.x); wv[2] = bflo(w0.y); wv[3] = bfhi(w0.y); wv[4] = bflo(w0.z); wv[5] = bfhi(w0.z); wv[6] = bflo(w0.w); wv[7] = bfhi(w0.w);
          wv[8] = bflo(w1.x); wv[9] = bfhi(w1.x); wv[10] = bflo(w1.y); wv[11] = bfhi(w1.y); wv[12] = bflo(w1.z); wv[13] = bfhi(w1.z); wv[14] = bflo(w1.w); wv[15] = bfhi(w1.w); }
        for (int b = 0; b < 8; ++b) { const f32x4* sp = (const f32x4*)(modf + b * 6144 + 3 * 1024 + 16 * F.lane); float s = 0.f;
#pragma unroll
            for (int q = 0; q < 4; ++q) { const f32x4 sv = sp[q]; s += sv.x * wv[4 * q] + sv.y * wv[4 * q + 1] + sv.z * wv[4 * q + 2] + sv.w * wv[4 * q + 3]; }
            s = wave_sum(s);
            if (F.lane == 0) bias5[b * 4096 + n] = s; }
    }
}
__device__ __forceinline__ void phase_ret_naive(const Frame& F, const Args& a) {
    LAS float* qs = (LAS float*)F.lds; LAS float* ks = qs + 256; LAS float* red = ks + 256;
    const bf16* RQ = (const bf16*)a.out; const bf16* RK = (const bf16*)((unsigned char*)a.out + 32 * MiB); bf16* RV = (bf16*)(a.ws + WS_R);
    float2* gns = (float2*)(a.ws + WS_GNS);
    for (int u = F.vcu; u < 256; u += F.G) {
        const int b = u >> 5, h = (u >> 3) & 3, es = u & 7, e = F.tid & 63, dg = F.tid >> 6;
        const float lg = __builtin_log2f(1.0f - __builtin_amdgcn_exp2f(-5.0f - (float)h)), cd = __builtin_amdgcn_exp2f(128.0f * lg);
        float T[32];
#pragma unroll
        for (int i = 0; i < 32; ++i) T[i] = 0.f;
        for (int s = 0; s < SEQ; ++s) {
            const size_t row = (size_t)b * SEQ + s;
            __syncthreads();
            if (F.tid < 256) qs[F.tid] = bf2f(RQ[row * 1024 + h * 256 + F.tid]); else ks[F.tid - 256] = bf2f(RK[row * 1024 + h * 256 + F.tid - 256]);
            const float vv = bf2f(RV[row * 2048 + h * 512 + es * 64 + e]);
            __syncthreads();
            float part = 0.f;
#pragma unroll
            for (int i = 0; i < 32; ++i) { const int d = dg * 32 + i; T[i] = fmaf(ks[d], vv, T[i]); part = fmaf(qs[d], T[i], part); }
            red[dg * 64 + e] = part;
            __syncthreads();
            if (F.tid < 64) { float o = 0.f;
#pragma unroll
                for (int j = 0; j < 8; ++j) o += red[j * 64 + F.tid];
                RV[row * 2048 + h * 512 + es * 64 + F.tid] = (bf16)pk2(o, 0.f);
                const float s1 = wave_sum(o), s2 = wave_sum(o * o);
                if (F.tid == 0) { gns[(row * 4 + h) * 16 + es * 2] = make_float2(s1, s2); gns[(row * 4 + h) * 16 + es * 2 + 1] = make_float2(0.f, 0.f); } }
            if ((s & 127) == 127) {
#pragma unroll
                for (int i = 0; i < 32; ++i) T[i] *= cd; }
        }
    }
    __syncthreads();
}
__device__ __forceinline__ void phase_gn(const Frame& F, const Args& a) {
    GRID_WAVES(F);
    const float2* gns = (const float2*)(a.ws + WS_GNS); const bf16* ro = (const bf16*)(a.ws + WS_R); bf16* sg = (bf16*)(a.ws + WS_R + 64 * MiB);
    const float* gg = a.in[7]; const float* gb = a.in[8];
    for (int row = gw; row < MTOK; row += NGW) {
        const float2 st = gns[(size_t)row * 64 + F.lane]; float s1 = st.x, s2 = st.y;
#pragma unroll
        for (int o = 1; o < 16; o <<= 1) { s1 += __shfl_xor(s1, o); s2 += __shfl_xor(s2, o); }
        const float mu = s1 * (1.0f / 512.0f), var = fmaxf(s2 * (1.0f / 512.0f) - mu * mu, 0.f), rstd = 1.0f / sqrtf(var + 1e-5f);
#pragma unroll
        for (int c = 0; c < 4; ++c) {
            const float muh = __shfl(mu, 16 * c), rsh = __shfl(rstd, 16 * c); const int col = (F.lane + 64 * c) * 8;
            const v4u rv = *(const v4u*)(ro + (size_t)row * 2048 + col), gv = *(const v4u*)(sg + (size_t)row * 2048 + col);
            const f32x4 g0 = *(const f32x4*)(gg + col), g1 = *(const f32x4*)(gg + col + 4), b0 = *(const f32x4*)(gb + col), b1 = *(const f32x4*)(gb + col + 4);
            float o[8]; const float r[8] = {bflo(rv.x), bfhi(rv.x), bflo(rv.y), bfhi(rv.y), bflo(rv.z), bfhi(rv.z), bflo(rv.w), bfhi(rv.w)};
            const float s[8] = {bflo(gv.x), bfhi(gv.x), bflo(gv.y), bfhi(gv.y), bflo(gv.z), bfhi(gv.z), bflo(gv.w), bfhi(gv.w)};
            const float gq[8] = {g0.x, g0.y, g0.z, g0.w, g1.x, g1.y, g1.z, g1.w}, bq[8] = {b0.x, b0.y, b0.z, b0.w, b1.x, b1.y, b1.z, b1.w};
#pragma unroll
            for (int j = 0; j < 8; ++j) o[j] = s[j] * ((r[j] - muh) * rsh * gq[j] + bq[j]);
            v4u w; w.x = pk2(o[0], o[1]); w.y = pk2(o[2], o[3]); w.z = pk2(o[4], o[5]); w.w = pk2(o[6], o[7]);
            *(v4u*)(sg + (size_t)row * 2048 + col) = w;
        }
    }
}
__device__ __forceinline__ void phase_final(const Frame& F, const Args& a) {
    GRID_WAVES(F);
    const float* rowp = (const float*)(a.ws + WS_ROWP2); const float* gf = a.in[15];
    for (int row = gw; row < MTOK; row += NGW) {
        float s = (F.lane < 16) ? rowp[(size_t)row * 16 + F.lane] : 0.f;
        s = wave_sum(s);
        const float rstd = 1.0f / sqrtf(s * (1.0f / DM) + 1e-6f);
        GAS f32x4* xr = (GAS f32x4*)(a.out + (size_t)row * DM) + F.lane;
#pragma unroll
        for (int j = 0; j < 4; ++j) { const f32x4 g = *(const f32x4*)(gf + 4 * F.lane + 256 * j); xr[64 * j] = xr[64 * j] * rstd * g; }
    }
}
#ifndef MK_PER_PHASE
#define MK_PER_PHASE 0
#endif
constexpr int N_PHASES = 15;
__global__ void __launch_bounds__(NWAVES * 64, 2) mega_fwd(Args args) {
    extern __shared__ __attribute__((aligned(16))) unsigned char lds_raw[];
    Frame F;
    F.lds = (LAS unsigned char*)lds_raw;
    F.tid = threadIdx.x; F.lane = F.tid & 63; F.wave = __builtin_amdgcn_readfirstlane(F.tid >> 6);
    F.G = gridDim.x; { const int bx = blockIdx.x; F.vcu = (F.G % 8 == 0) ? (bx % 8) * (F.G / 8) + bx / 8 : bx; }
    volatile LAS unsigned* MISC = (volatile LAS unsigned*)(F.lds + MISC_OFF);
    if (F.tid < 64) MISC[F.tid] = 0u;
    __syncthreads();
    unsigned char* ws = args.ws; unsigned char* dob = (unsigned char*)args.out;
    cg::grid_group grid = cg::this_grid();
    XcdBarrier bar; bar.bar = (unsigned*)(ws + WS_CTL) + CW_BAR; bar.x = 0; bar.st = nullptr;
    if (!MK_PER_PHASE) bar = xcd_barrier_post((unsigned*)(ws + WS_CTL) + CW_BAR, MISC + 8);
    const int lo = args.ph_lo, hi = args.ph_hi;
#define IN(k) (lo <= (k) && (k) < hi)
#define SEAM(k) do { if (IN(k) && IN((k) + 1)) { if ((k) == 0) grid.sync(); else xcd_barrier(bar); } } while (0)
    typedef pg8::bf16_t b16;
    b16* HB = (b16*)(ws + WS_HB); const b16* WIN = (const b16*)(ws + WS_WIN);
    const float* modf = (const float*)(ws + WS_MODF);

    if (IN(0)) { phase_p0(F, args); } SEAM(0);
    if (IN(1)) { phase_p1(F, args); } SEAM(1);
    if (IN(2)) {
        pg8::Gemm g{HB, WIN + (size_t)6144 * DM, MTOK, 4608, DM}; pg8::StaticOrder S; S.init(MTOK, 4608, F.G, (int)blockIdx.x);
        pg8::EpiProj<0> E{(b16*)(ws + WS_R), nullptr, nullptr, nullptr, nullptr};
        pg8::gemm_phase<pg8::EpiProj<0>, pg8::StaticOrder, true, true>(F.lds, g, S, E);
    } SEAM(2);
    if (IN(3)) { phase_attn_naive(F, args); } SEAM(3);
    if (IN(4)) { phase_merge(F, args); } SEAM(4);
    if (IN(5)) {
        pg8::Gemm g{HB, WIN, MTOK, 6144, DM}; pg8::StaticOrder S; S.init(MTOK, 6144, F.G, (int)blockIdx.x);
        pg8::EpiProj<1> E{(b16*)dob, (b16*)(dob + 32 * MiB), (b16*)(ws + WS_R), (b16*)(ws + WS_R + 64 * MiB), (const float*)(ws + WS_ROPE)};
        pg8::gemm_phase<pg8::EpiProj<1>, pg8::StaticOrder, true, true>(F.lds, g, S, E);
    } SEAM(5);
    if (IN(6)) { phase_ret_naive(F, args); } SEAM(6);
    if (IN(7)) { phase_gn(F, args); } SEAM(7);
    if (IN(8)) {
        pg8::Gemm g{HB, WIN + (size_t)10752 * DM, MTOK, 2048, DM}; pg8::StaticOrder S; S.init(MTOK, 2048, F.G, (int)blockIdx.x);
        pg8::EpiProj<2> E{(b16*)(dob + 32 * MiB), (b16*)(ws + WS_R), nullptr, nullptr, nullptr};
        pg8::gemm_phase<pg8::EpiProj<2>, pg8::StaticOrder, true, true>(F.lds, g, S, E);
    } SEAM(8);
    if (IN(9)) {
        pg8::Gemm g{(const b16*)(ws + WS_ATT), (const b16*)(ws + WS_WATT), MTOK, DM, 512}; pg8::StaticOrder S; S.init(MTOK, DM, F.G, (int)blockIdx.x);
        pg8::EpiT3 E{(const b16*)(ws + WS_R), (b16*)dob};
        pg8::gemm_phase<pg8::EpiT3, pg8::StaticOrder, true, true>(F.lds, g, S, E);
    }
    if (IN(10)) {
        pg8::Gemm g{(const b16*)(ws + WS_R + 64 * MiB), (const b16*)(ws + WS_WRET), MTOK, DM, 2048}; pg8::StaticOrder S; S.init(MTOK, DM, F.G, (int)blockIdx.x);
        pg8::EpiMerged E{(const b16*)(dob + 32 * MiB), (const b16*)dob, (b16*)(ws + WS_R + 32 * MiB)};
        pg8::gemm_phase<pg8::EpiMerged, pg8::StaticOrder, true, true>(F.lds, g, S, E);
    } SEAM(10);
    if (IN(11)) {
        pg8::Gemm g{(const b16*)(ws + WS_R + 32 * MiB), (const b16*)(ws + WS_WO), MTOK, DM, DM}; pg8::StaticOrder S; S.init(MTOK, DM, F.G, (int)blockIdx.x);
        pg8::EpiX1 E{args.in[0], modf, args.in[12], args.out, HB, (float*)(ws + WS_ROWP)};
        pg8::gemm_phase<pg8::EpiX1, pg8::StaticOrder, true, true>(F.lds, g, S, E);
    } SEAM(11);
    if (IN(12)) {
        pg8::Gemm g{HB, (const b16*)(ws + WS_WFF1), MTOK, DFF, DM}; pg8::StaticOrder S; S.init(MTOK, DFF, F.G, (int)blockIdx.x);
        pg8::EpiFF1 E{(const float*)(ws + WS_ROWP), (const float*)(ws + WS_BIAS5), (b16*)(ws + WS_R)};
        pg8::gemm_phase<pg8::EpiFF1, pg8::StaticOrder, true, true>(F.lds, g, S, E);
    } SEAM(12);
    if (IN(13)) {
        pg8::Gemm g{(const b16*)(ws + WS_R), (const b16*)(ws + WS_WFF2), MTOK, DM, DFF}; pg8::StaticOrder S; S.init(MTOK, DM, F.G, (int)blockIdx.x);
        pg8::EpiX2 E{modf, args.out, (float*)(ws + WS_ROWP2)};
        pg8::gemm_phase<pg8::EpiX2, pg8::StaticOrder, true, true>(F.lds, g, S, E);
    } SEAM(13);
    if (IN(14)) { phase_final(F, args); }
#undef IN
#undef SEAM
}


extern "C" void kernel_launch(void* const* d_in, const int* in_sizes, int n_in, void* d_out, int out_size, void* d_ws, size_t ws_size, hipStream_t stream) {
    static int grid = 0;
    if (grid == 0) {
        if (n_in != 16 || out_size != MTOK * DM || ws_size < WS_END) { fprintf(stderr, "kernel_launch: unexpected shapes (n_in %d out %d ws %zu)\n", n_in, out_size, ws_size); grid = -1; return; }
        int dev = 0, cus = 0, per_cu = 0;
        (void)hipGetDevice(&dev); (void)hipDeviceGetAttribute(&cus, hipDeviceAttributeMultiprocessorCount, dev);
        if (hipFuncSetAttribute((const void*)mega_fwd, hipFuncAttributeMaxDynamicSharedMemorySize, LDS_BYTES) != hipSuccess) { fprintf(stderr, "kernel_launch: hipFuncSetAttribute failed\n"); grid = -1; return; }
        if (hipOccupancyMaxActiveBlocksPerMultiprocessor(&per_cu, (const void*)mega_fwd, NWAVES * 64, LDS_BYTES) != hipSuccess || per_cu < 1) { fprintf(stderr, "kernel_launch: occupancy query says %d\n", per_cu); (void)hipGetLastError(); per_cu = 1; }
        grid = cus;
        if (grid != 256) fprintf(stderr, "kernel_launch: %d CUs; the phase program assumes 256\n", grid);
    }
    if (grid < 0) return;
    (void)hipMemsetAsync((char*)d_ws + WS_CTL, 0, CTL_ZERO_BYTES, stream);
    Args a{};
    for (int i = 0; i < 16; ++i) a.in[i] = (const float*)d_in[i];
    a.out = (float*)d_out; a.ws = (unsigned char*)d_ws;
#if MK_PER_PHASE
    for (int p = 0; p < N_PHASES; ++p) { a.ph_lo = p; a.ph_hi = p + 1; hipLaunchKernelGGL(mega_fwd, dim3(grid), dim3(NWAVES * 64), LDS_BYTES, stream, a); }
#else
    a.ph_lo = 0; a.ph_hi = N_PHASES;
    void* kargs[] = {&a};
    const hipError_t e = hipLaunchCooperativeKernel((const void*)mega_fwd, dim3(grid), dim3(NWAVES * 64), kargs, LDS_BYTES, stream);
    if (e != hipSuccess) fprintf(stderr, "kernel_launch: cooperative launch failed: %s (grid %d)\n", hipGetErrorString(e), grid);
#endif
}
```

```cpp
#include <hip/hip_runtime.h>
#include <hip/hip_cooperative_groups.h>
#include <cstdio>
#include <cstdint>
namespace cg = cooperative_groups;
namespace pg8 {
#define PG8_LAS __attribute__((address_space(3)))
typedef unsigned short bf16_t;
typedef short bf16x8 __attribute__((ext_vector_type(8)));
typedef float f32x4 __attribute__((ext_vector_type(4)));
typedef unsigned u32x4 __attribute__((ext_vector_type(4)));
constexpr int BM = 256, BK = 64, HALF = 128, HTB = HALF * BK * 2  , STAGE_BYTES = 8 * HTB, NXCD = 8, WGM = 8;

__host__ __device__ __forceinline__ int lds_byte(int r, int c) { const int st = (r >> 4) * 2 + (c >> 5), rr = r & 15, cc = c & 31, ob = rr * 64 + cc * 2; return st * 1024 + (ob ^ (((ob >> 9) & 1) << 5)); }
__host__ __device__ __forceinline__ void stage_rc(int b, int& R, int& C) { const int st = b / 1024, sb = b % 1024, swz = sb ^ (((sb >> 9) & 1) << 5); R = (st >> 1) * 16 + swz / 64; C = (st & 1) * 32 + (swz % 64) / 2; }
__host__ __device__ __forceinline__ int perm32(int rho) { const int n = rho >> 4, i = rho & 15; return 8 * (i >> 2) + 4 * n + (i & 3); }

struct Unit { int pm, pn; };
struct Gemm { const bf16_t* A; const bf16_t* Bt; int M, N, K; };

struct StaticOrder {
    int nM, nN, nwg, G, c;
    __host__ __device__ void init(int M, int N, int G_, int c_) { nM = M / BM; nN = N / BM; nwg = nM * nN; G = G_; c = c_; }
    __host__ __device__ bool next(int i, Unit& u) const {
        const long L = (long)i * G + c; if (L >= nwg) return false;
        int wgid = (int)L; { const int q = nwg / NXCD, r = nwg % NXCD, xcd = wgid % NXCD, off = wgid / NXCD; wgid = (xcd < r ? xcd * (q + 1) : r * (q + 1) + (xcd - r) * q) + off; }
        const int nig = WGM * nN, gid = wgid / nig, fm = gid * WGM, gsz = (nM - fm) < WGM ? (nM - fm) : WGM;
        u.pm = fm + ((wgid % nig) % gsz); u.pn = (wgid % nig) / gsz; return true;
    }
    __device__ __forceinline__ void a_ready(const Unit&) const {}
    __device__ __forceinline__ void done(const Unit&) const {}
};

typedef float f32x2_t __attribute__((ext_vector_type(2))); typedef __bf16 bf16x2_t __attribute__((ext_vector_type(2)));
__device__ __forceinline__ unsigned cvt_pk_bf16(float lo, float hi) { f32x2_t v = {lo, hi}; bf16x2_t b = __builtin_convertvector(v, bf16x2_t); return __builtin_bit_cast(unsigned, b); }
__device__ __forceinline__ void st8(bf16_t* p, f32x4 a, f32x4 b) { u32x4 w; w.x = cvt_pk_bf16(a[0], a[1]); w.y = cvt_pk_bf16(a[2], a[3]); w.z = cvt_pk_bf16(b[0], b[1]); w.w = cvt_pk_bf16(b[2], b[3]); *(u32x4*)p = w; }
__device__ __forceinline__ float bfl(unsigned w) { return __uint_as_float(w << 16); }
__device__ __forceinline__ float bfh(unsigned w) { return __uint_as_float(w & 0xffff0000u); }
__device__ __forceinline__ void ld8(const bf16_t* p, f32x4& a, f32x4& b) { const u32x4 w = *(const u32x4*)p; a = (f32x4){bfl(w.x), bfh(w.x), bfl(w.y), bfh(w.y)}; b = (f32x4){bfl(w.z), bfh(w.z), bfl(w.w), bfh(w.w)}; }
__device__ __forceinline__ f32x4 sigmoid4(f32x4 v) { f32x4 o;
#pragma unroll
    for (int j = 0; j < 4; ++j) o[j] = __builtin_amdgcn_rcpf(1.f + __builtin_amdgcn_exp2f(-1.4426950408889634f * v[j])); return o; }

constexpr float QSCALE = 0.08838834764831845f * 1.4426950408889634f;
constexpr size_t MiB_ = 1u << 20;

template <int PASS> struct EpiProj {
    static constexpr bool PERM = true, AFTER_DRAIN = false;
    bf16_t* d0; bf16_t* d1; bf16_t* d2; bf16_t* d3; const float* rope;
    __device__ __forceinline__ void operator()(const f32x4 (&acc)[2][2][4][2], const Unit& u, int wr, int wc, int fr, int fq) const {
        const int row0 = u.pm * BM + wr * 64 + fr, cl0 = wc * 32 + 8 * fq, pn = u.pn;
        if (PASS == 0) {
            const int part = pn >> 1; bf16_t* base = d0 + (size_t)part * (8 * MiB_) + (pn & 1) * 256 + cl0;
            const float sc = (part % 3 == 0) ? QSCALE : 1.0f;
#pragma unroll
            for (int ai = 0; ai < 2; ++ai)
#pragma unroll
                for (int m = 0; m < 4; ++m) { bf16_t* rp = base + (size_t)(row0 + ai * HALF + m * 16) * 512;
#pragma unroll
                    for (int bj = 0; bj < 2; ++bj) st8(rp + bj * HALF, acc[ai][bj][m][0] * sc, acc[ai][bj][m][1] * sc); }
        } else if (PASS == 1) {
            if (pn < 8) {
                const int head = pn & 3; const bool isk = pn >= 4; bf16_t* base = (isk ? d1 : d0) + head * 256 + cl0;
                const float lg = __builtin_log2f(1.0f - __builtin_amdgcn_exp2f(-5.0f - (float)head));
#pragma unroll
                for (int ai = 0; ai < 2; ++ai)
#pragma unroll
                    for (int m = 0; m < 4; ++m) { const int row = row0 + ai * HALF + m * 16, pos = row & 2047, ci = pos & 127;
                        const float e = (float)(ci + 1) * lg; const float sc = isk ? 0.0625f * __builtin_amdgcn_exp2f(-e) : __builtin_amdgcn_exp2f(e);
                        const f32x4* rp = (const f32x4*)(rope + ((size_t)pos * 128 + cl0) * 2);
                        f32x4 o1[2], o2[2];
#pragma unroll
                        for (int n = 0; n < 2; ++n) { const f32x4 ra = rp[2 * n], rb = rp[2 * n + 1]; const f32x4 x1 = acc[ai][0][m][n], x2 = acc[ai][1][m][n];
                            const f32x4 cs = (f32x4){ra[0], ra[2], rb[0], rb[2]}, sn = (f32x4){ra[1], ra[3], rb[1], rb[3]};
                            o1[n] = (x1 * cs - x2 * sn) * sc; o2[n] = (x1 * sn + x2 * cs) * sc; }
                        bf16_t* dp = base + (size_t)row * 1024; st8(dp, o1[0], o1[1]); st8(dp + HALF, o2[0], o2[1]); }
            } else {
                const bool isg = pn >= 16; bf16_t* base = (isg ? d3 : d2) + ((pn - 8) & 7) * 256 + cl0;
#pragma unroll
                for (int ai = 0; ai < 2; ++ai)
#pragma unroll
                    for (int m = 0; m < 4; ++m) { bf16_t* rp = base + (size_t)(row0 + ai * HALF + m * 16) * 2048;
#pragma unroll
                        for (int bj = 0; bj < 2; ++bj) { f32x4 a = acc[ai][bj][m][0], b = acc[ai][bj][m][1];
                            if (isg) { a = a * sigmoid4(a); b = b * sigmoid4(b); }
                            st8(rp + bj * HALF, a, b); } }
            }
        } else {
            bf16_t* base = (pn >= 4 ? d1 : d0) + (pn & 3) * 256 + cl0;
#pragma unroll
            for (int ai = 0; ai < 2; ++ai)
#pragma unroll
                for (int m = 0; m < 4; ++m) { bf16_t* rp = base + (size_t)(row0 + ai * HALF + m * 16) * 1024;
#pragma unroll
                    for (int bj = 0; bj < 2; ++bj) { f32x4 a = acc[ai][bj][m][0], b = acc[ai][bj][m][1];
                        if (PASS == 2) { a = sigmoid4(a); b = sigmoid4(b); }
                        if (PASS == 4) {
#pragma unroll
                            for (int j = 0; j < 4; ++j) { a[j] = 1.0f / (1.0f + __expf(-a[j])); b[j] = 1.0f / (1.0f + __expf(-b[j])); } }
                        st8(rp + bj * HALF, a, b); } }
        }
    }
};
struct GateOrder { Unit base;
    __device__ bool next(int i, Unit& u) const { if (i >= 2) return false; u.pm = base.pm; u.pn = base.pn + 4 * i; return true; }
    __device__ __forceinline__ void a_ready(const Unit&) const {}
    __device__ __forceinline__ void done(const Unit&) const {} };
struct EpiT3 { static constexpr bool PERM = true, AFTER_DRAIN = false; const bf16_t* sb; bf16_t* t3;
    __device__ __forceinline__ void operator()(const f32x4 (&acc)[2][2][4][2], const Unit& u, int wr, int wc, int fr, int fq) const {
        const int row0 = u.pm * BM + wr * 64 + fr, col0 = u.pn * BM + wc * 32 + 8 * fq;
#pragma unroll
        for (int ai = 0; ai < 2; ++ai)
#pragma unroll
            for (int m = 0; m < 4; ++m) { const size_t off = (size_t)(row0 + ai * HALF + m * 16) * 1024 + col0;
#pragma unroll
                for (int bj = 0; bj < 2; ++bj) { f32x4 ga, gb; ld8(sb + off + bj * HALF, ga, gb); st8(t3 + off + bj * HALF, acc[ai][bj][m][0] * ga, acc[ai][bj][m][1] * gb); } }
    } };
struct EpiMerged { static constexpr bool PERM = true, AFTER_DRAIN = false; const bf16_t* sa; const bf16_t* t3; bf16_t* mg;
    __device__ __forceinline__ void operator()(const f32x4 (&acc)[2][2][4][2], const Unit& u, int wr, int wc, int fr, int fq) const {
        const int row0 = u.pm * BM + wr * 64 + fr, col0 = u.pn * BM + wc * 32 + 8 * fq;
#pragma unroll
        for (int ai = 0; ai < 2; ++ai)
#pragma unroll
            for (int m = 0; m < 4; ++m) { const size_t off = (size_t)(row0 + ai * HALF + m * 16) * 1024 + col0;
#pragma unroll
                for (int bj = 0; bj < 2; ++bj) { f32x4 ga, gb, ta, tb; ld8(sa + off + bj * HALF, ga, gb); ld8(t3 + off + bj * HALF, ta, tb);
                    st8(mg + off + bj * HALF, acc[ai][bj][m][0] * ga + ta, acc[ai][bj][m][1] * gb + tb); } }
    } };
struct EpiX1 { static constexpr bool PERM = true, AFTER_DRAIN = false; const float* x; const float* modf; const float* n2g; float* x1; bf16_t* a5; float* rowp;
    __device__ __forceinline__ void operator()(const f32x4 (&acc)[2][2][4][2], const Unit& u, int wr, int wc, int fr, int fq) const {
        const int row0 = u.pm * BM + wr * 64 + fr, col0 = u.pn * BM + wc * 32 + 8 * fq, b = (u.pm * BM) >> 11;
        f32x4 g1[2][2], gg[2][2];
#pragma unroll
        for (int bj = 0; bj < 2; ++bj)
#pragma unroll
            for (int n = 0; n < 2; ++n) { const int c = col0 + bj * HALF + 4 * n; g1[bj][n] = *(const f32x4*)(modf + b * 6144 + 2 * 1024 + c);
                gg[bj][n] = *(const f32x4*)(n2g + c) * (*(const f32x4*)(modf + b * 6144 + 4 * 1024 + c) + 1.0f); }
#pragma unroll
        for (int ai = 0; ai < 2; ++ai)
#pragma unroll
            for (int m = 0; m < 4; ++m) { const int row = row0 + ai * HALF + m * 16; const size_t off = (size_t)row * 1024 + col0; float ss = 0.f;
#pragma unroll
                for (int bj = 0; bj < 2; ++bj) { f32x4 v[2];
#pragma unroll
                    for (int n = 0; n < 2; ++n) { v[n] = *(const f32x4*)(x + off + bj * HALF + 4 * n) + g1[bj][n] * acc[ai][bj][m][n]; *(f32x4*)(x1 + off + bj * HALF + 4 * n) = v[n];
                        ss += (v[n][0] * v[n][0] + v[n][1] * v[n][1]) + (v[n][2] * v[n][2] + v[n][3] * v[n][3]); }
                    st8(a5 + off + bj * HALF, v[0] * gg[bj][0], v[1] * gg[bj][1]); }
                ss += __shfl_xor(ss, 16); ss += __shfl_xor(ss, 32);
                if (fq == 0) rowp[(size_t)row * 16 + u.pn * 4 + wc] = ss; }
    } };
struct EpiFF1 { static constexpr bool PERM = true, AFTER_DRAIN = false; const float* rowp; const float* bias5; bf16_t* uo;
    __device__ __forceinline__ void operator()(const f32x4 (&acc)[2][2][4][2], const Unit& u, int wr, int wc, int fr, int fq) const {
        const int row0 = u.pm * BM + wr * 64 + fr, col0 = u.pn * BM + wc * 32 + 8 * fq, b = (u.pm * BM) >> 11;
        f32x4 bs[2][2];
#pragma unroll
        for (int bj = 0; bj < 2; ++bj)
#pragma unroll
            for (int n = 0; n < 2; ++n) bs[bj][n] = *(const f32x4*)(bias5 + b * 4096 + col0 + bj * HALF + 4 * n);
#pragma unroll
        for (int ai = 0; ai < 2; ++ai)
#pragma unroll
            for (int m = 0; m < 4; ++m) { const int row = row0 + ai * HALF + m * 16; const f32x4* rp = (const f32x4*)(rowp + (size_t)row * 16);
                const f32x4 s4 = (rp[0] + rp[1]) + (rp[2] + rp[3]); const float rstd = __builtin_amdgcn_rsqf(((s4[0] + s4[1]) + (s4[2] + s4[3])) * (1.0f / 1024.0f) + 1e-6f);
#pragma unroll
                for (int bj = 0; bj < 2; ++bj) { f32x4 v[2];
#pragma unroll
                    for (int n = 0; n < 2; ++n) { v[n] = acc[ai][bj][m][n] * rstd + bs[bj][n];
#pragma unroll
                        for (int j = 0; j < 4; ++j) { const float r = v[n][j] > 0.f ? v[n][j] : 0.f; v[n][j] = r * r; } }
                    st8(uo + (size_t)row * 4096 + col0 + bj * HALF, v[0], v[1]); } }
    } };
struct EpiX2 { static constexpr bool PERM = true, AFTER_DRAIN = false; const float* modf; float* x1; float* rowp;
    __device__ __forceinline__ void operator()(const f32x4 (&acc)[2][2][4][2], const Unit& u, int wr, int wc, int fr, int fq) const {
        const int row0 = u.pm * BM + wr * 64 + fr, col0 = u.pn * BM + wc * 32 + 8 * fq, b = (u.pm * BM) >> 11;
        f32x4 g2[2][2];
#pragma unroll
        for (int bj = 0; bj < 2; ++bj)
#pragma unroll
            for (int n = 0; n < 2; ++n) g2[bj][n] = *(const f32x4*)(modf + b * 6144 + 5 * 1024 + col0 + bj * HALF + 4 * n);
#pragma unroll
        for (int ai = 0; ai < 2; ++ai)
#pragma unroll
            for (int m = 0; m < 4; ++m) { const int row = row0 + ai * HALF + m * 16; const size_t off = (size_t)row * 1024 + col0; float ss = 0.f;
#pragma unroll
                for (int bj = 0; bj < 2; ++bj)
#pragma unroll
                    for (int n = 0; n < 2; ++n) { float* p = x1 + off + bj * HALF + 4 * n; const f32x4 v = *(const f32x4*)p + g2[bj][n] * acc[ai][bj][m][n]; *(f32x4*)p = v;
                        ss += (v[0] * v[0] + v[1] * v[1]) + (v[2] * v[2] + v[3] * v[3]); }
                ss += __shfl_xor(ss, 16); ss += __shfl_xor(ss, 32);
                if (fq == 0) rowp[(size_t)row * 16 + u.pn * 4 + wc] = ss; }
    } };
template <class Epi, class Sched, bool ALIGN_EPI = false, bool SP2 = false>
__device__ __forceinline__ void gemm_phase(PG8_LAS unsigned char* lds, const Gemm g, const Sched& S, const Epi& E) {
    const int tid = threadIdx.x, wid = __builtin_amdgcn_readfirstlane(tid >> 6), lane = tid & 63, wr = wid >> 2, wc = wid & 3, fr = lane & 15, fq = lane >> 4;
    const int K = g.K, nt = K / BK;
    unsigned voffA[2], voffB[2];
#pragma unroll
    for (int i = 0; i < 2; ++i) { int R, C; stage_rc(tid * 16 + i * 8192, R, C); const int Rb = Epi::PERM ? ((R & ~31) + perm32(R & 31)) : R;
        voffA[i] = (unsigned)(R * K + C) * 2u; voffB[i] = (unsigned)(Rb * K + C) * 2u; }
    const size_t kstep = (size_t)(BK * 2);
    const size_t hstep = (size_t)HALF * K * 2;
    const size_t tstep = 2 * hstep;
    const unsigned ldsw = (unsigned)wid * 1024u;
    const int aoff = lds_byte(wr * 64 + fr, fq * 8), boff = lds_byte(wc * 32 + fr, fq * 8);
#define PG8_SA(b, h) (((b) * 2 + (h)) * HTB)
#define PG8_SB(b, h) ((4 + (b) * 2 + (h)) * HTB)
#define PG8_STAGE(bufoff, gbase, voff) do { _Pragma("unroll") for (int _i = 0; _i < 2; ++_i) \
        __builtin_amdgcn_global_load_lds((const unsigned*)((const char*)(gbase) + (voff)[_i]), (PG8_LAS unsigned*)(lds + (bufoff) + ldsw + _i * 8192), 16, 0, 0); } while (0)
#define PG8_LDA(dst, b, h) do { _Pragma("unroll") for (int m = 0; m < 4; ++m) _Pragma("unroll") for (int k = 0; k < 2; ++k) dst[m][k] = *(const PG8_LAS bf16x8*)(lds + PG8_SA(b, h) + aoff + m * 2048 + k * 1024); } while (0)
#define PG8_LDB(dst, b, h) do { _Pragma("unroll") for (int n = 0; n < 2; ++n) _Pragma("unroll") for (int k = 0; k < 2; ++k) dst[n][k] = *(const PG8_LAS bf16x8*)(lds + PG8_SB(b, h) + boff + n * 2048 + k * 1024); } while (0)
#define PG8_MMA(ai, bj, At, Bt) do { __builtin_amdgcn_s_setprio(1); _Pragma("unroll") for (int m = 0; m < 4; ++m) _Pragma("unroll") for (int n = 0; n < 2; ++n) _Pragma("unroll") for (int k = 0; k < 2; ++k) \
        acc[ai][bj][m][n] = __builtin_amdgcn_mfma_f32_16x16x32_bf16(Bt[n][k], At[m][k], acc[ai][bj][m][n], 0, 0, 0); __builtin_amdgcn_s_setprio(0); } while (0)
#define PG8_WAIT_V(n) asm volatile("s_waitcnt vmcnt(" #n ")" ::: "memory")
#define PG8_WAIT_L(n) asm volatile("s_waitcnt lgkmcnt(" #n ")" ::: "memory")
#define PG8_BAR __builtin_amdgcn_s_barrier()
#define PG8_SCHED __builtin_amdgcn_sched_barrier(0)
    Unit cur, nxt; int ui = 0;
    if (!S.next(0, cur)) return;
    f32x4 acc[2][2][4][2];
#pragma unroll
    for (int a = 0; a < 2; ++a)
#pragma unroll
        for (int b = 0; b < 2; ++b)
#pragma unroll
            for (int m = 0; m < 4; ++m)
#pragma unroll
                for (int n = 0; n < 2; ++n) acc[a][b][m][n] = (f32x4){0.f, 0.f, 0.f, 0.f};
    bf16x8 At[4][2], B0[2][2], B1[2][2];
    const char* cA = (const char*)g.A + (size_t)cur.pm * tstep; const char* cB = (const char*)g.Bt + (size_t)cur.pn * tstep;
    S.a_ready(cur);
    if constexpr (SP2) {
        PG8_STAGE(PG8_SB(0, 0), cB, voffB); PG8_STAGE(PG8_SB(0, 1), cB + hstep, voffB); PG8_STAGE(PG8_SA(0, 0), cA, voffA); PG8_STAGE(PG8_SA(0, 1), cA + hstep, voffA);
        if (wr == 1) PG8_BAR;
        PG8_WAIT_V(2); PG8_BAR;
        PG8_STAGE(PG8_SB(1, 0), cB + kstep, voffB); PG8_STAGE(PG8_SA(1, 0), cA + kstep, voffA); PG8_STAGE(PG8_SB(1, 1), cB + hstep + kstep, voffB);
        PG8_WAIT_V(6); PG8_BAR;
    } else {
        PG8_STAGE(PG8_SB(0, 0), cB, voffB); PG8_STAGE(PG8_SA(0, 0), cA, voffA); PG8_STAGE(PG8_SB(0, 1), cB + hstep, voffB); PG8_STAGE(PG8_SA(0, 1), cA + hstep, voffA);
        if (wr == 1) PG8_BAR;
        PG8_WAIT_V(4); PG8_BAR;
        PG8_STAGE(PG8_SB(1, 0), cB + kstep, voffB); PG8_STAGE(PG8_SA(1, 0), cA + kstep, voffA); PG8_STAGE(PG8_SB(1, 1), cB + hstep + kstep, voffB);
        PG8_WAIT_V(6); PG8_BAR;
    }
    for (;;) {
        const bool has_next = S.next(ui + 1, nxt);
        const char* nA = has_next ? (const char*)g.A + (size_t)nxt.pm * tstep : cA; const char* nB = has_next ? (const char*)g.Bt + (size_t)nxt.pn * tstep : cB;
        for (int t = 0; t < nt; t += 2) {
            const bool last = (t == nt - 2);
            const char* a1 = cA + (size_t)(t + 1) * kstep;
            const char* a2 = last ? nA : cA + (size_t)(t + 2) * kstep; const char* b2 = last ? nB : cB + (size_t)(t + 2) * kstep;
            const char* a3 = a2 + kstep; const char* b3 = b2 + kstep;
            if (last && has_next) S.a_ready(nxt);
            if constexpr (SP2) {
            PG8_LDB(B0, 0, 0); PG8_LDB(B1, 0, 1); PG8_SCHED; PG8_LDA(At, 0, 0); PG8_STAGE(PG8_SA(1, 1), a1 + hstep, voffA);
            PG8_WAIT_V(8); PG8_WAIT_L(0); PG8_BAR; PG8_MMA(0, 0, At, B0); PG8_MMA(0, 1, At, B1); PG8_BAR; PG8_SCHED;
            PG8_LDA(At, 0, 1); PG8_STAGE(PG8_SB(0, 0), b2, voffB); PG8_STAGE(PG8_SB(0, 1), b2 + hstep, voffB); PG8_STAGE(PG8_SA(0, 0), a2, voffA);
            PG8_WAIT_V(8); PG8_WAIT_L(0); PG8_BAR; PG8_MMA(1, 0, At, B0); PG8_MMA(1, 1, At, B1); PG8_BAR; PG8_SCHED;
            PG8_LDB(B0, 1, 0); PG8_LDB(B1, 1, 1); PG8_SCHED; PG8_LDA(At, 1, 0); PG8_STAGE(PG8_SA(0, 1), a2 + hstep, voffA);
            PG8_WAIT_V(8); PG8_WAIT_L(0); PG8_BAR; PG8_MMA(0, 0, At, B0); PG8_MMA(0, 1, At, B1); PG8_BAR; PG8_SCHED;
            PG8_LDA(At, 1, 1); PG8_STAGE(PG8_SB(1, 0), b3, voffB); PG8_STAGE(PG8_SB(1, 1), b3 + hstep, voffB); PG8_STAGE(PG8_SA(1, 0), a3, voffA);
            PG8_WAIT_V(8); PG8_WAIT_L(0); PG8_BAR; PG8_MMA(1, 0, At, B0); PG8_MMA(1, 1, At, B1); PG8_BAR; PG8_SCHED;
            } else {
            PG8_LDB(B0, 0, 0); PG8_SCHED; PG8_LDA(At, 0, 0); PG8_STAGE(PG8_SA(1, 1), a1 + hstep, voffA);
            PG8_WAIT_L(8); PG8_BAR; PG8_WAIT_L(0); PG8_MMA(0, 0, At, B0); PG8_BAR; PG8_SCHED;
            PG8_LDB(B1, 0, 1); PG8_STAGE(PG8_SB(0, 0), b2, voffB);
            PG8_BAR; PG8_WAIT_L(0); PG8_MMA(0, 1, At, B1); PG8_BAR;
            PG8_LDA(At, 0, 1); PG8_STAGE(PG8_SA(0, 0), a2, voffA);
            PG8_BAR; PG8_WAIT_L(0); PG8_MMA(1, 0, At, B0); PG8_BAR; PG8_SCHED;
            PG8_STAGE(PG8_SB(0, 1), b2 + hstep, voffB);
            PG8_WAIT_V(6); PG8_BAR; PG8_MMA(1, 1, At, B1); PG8_BAR;
            PG8_LDB(B0, 1, 0); PG8_SCHED; PG8_LDA(At, 1, 0); PG8_STAGE(PG8_SA(0, 1), a2 + hstep, voffA);
            PG8_WAIT_L(8); PG8_BAR; PG8_WAIT_L(0); PG8_MMA(0, 0, At, B0); PG8_BAR; PG8_SCHED;
            PG8_LDB(B1, 1, 1); PG8_STAGE(PG8_SB(1, 0), b3, voffB);
            PG8_BAR; PG8_WAIT_L(0); PG8_MMA(0, 1, At, B1); PG8_BAR;
            PG8_LDA(At, 1, 1); PG8_STAGE(PG8_SA(1, 0), a3, voffA);
            PG8_BAR; PG8_WAIT_L(0); PG8_MMA(1, 0, At, B0); PG8_BAR; PG8_SCHED;
            PG8_STAGE(PG8_SB(1, 1), b3 + hstep, voffB);
            PG8_WAIT_V(6); PG8_BAR; PG8_MMA(1, 1, At, B1); PG8_BAR;
            }
        }
        if constexpr (ALIGN_EPI) { if (wr == 0) PG8_BAR; }
        if constexpr (!Epi::AFTER_DRAIN) { E(acc, cur, wr, wc, fr, fq); S.done(cur); }
        if (!has_next) break;
#pragma unroll
        for (int a = 0; a < 2; ++a)
#pragma unroll
            for (int b = 0; b < 2; ++b)
#pragma unroll
                for (int m = 0; m < 4; ++m)
#pragma unroll
                    for (int n = 0; n < 2; ++n) acc[a][b][m][n] = (f32x4){0.f, 0.f, 0.f, 0.f};
        cur = nxt; cA = nA; cB = nB; ++ui;
        if constexpr (ALIGN_EPI) { if (wr == 1) PG8_BAR; }
    }
    PG8_WAIT_V(0);
    if constexpr (!ALIGN_EPI) { if (wr == 0) PG8_BAR; }
    PG8_BAR;
    if constexpr (Epi::AFTER_DRAIN) { E.fused(acc, cur, wr, wc, fr, fq, lds, wid, lane); S.done(cur); }
#undef PG8_SA
#undef PG8_SB
#undef PG8_STAGE
#undef PG8_LDA
#undef PG8_LDB
#undef PG8_MMA
#undef PG8_WAIT_V
#undef PG8_WAIT_L
#undef PG8_BAR
#undef PG8_SCHED
}
}
#define GAS __attribute__((address_space(1)))
#define LAS __attribute__((address_space(3)))
typedef unsigned short bf16;
typedef unsigned v4u __attribute__((ext_vector_type(4)));
typedef float f32x4 __attribute__((ext_vector_type(4)));
typedef short bf16x8 __attribute__((ext_vector_type(8)));
typedef GAS unsigned gu32;
typedef GAS unsigned long long gu64;
#define RLX_AGENT __ATOMIC_RELAXED, __HIP_MEMORY_SCOPE_AGENT
#define LDS_WAIT() asm volatile("s_waitcnt lgkmcnt(0)" ::: "memory")
#define VM_WAIT() asm volatile("s_waitcnt vmcnt(0)" ::: "memory")
__device__ __forceinline__ unsigned long long rt() { return __builtin_amdgcn_s_memrealtime(); }
__device__ __forceinline__ unsigned f2bf(float f) { unsigned u = __builtin_bit_cast(unsigned, f); return (u + 0x7fffu + ((u >> 16) & 1u)) >> 16; }
__device__ __forceinline__ unsigned pk2(float lo, float hi) { return f2bf(lo) | (f2bf(hi) << 16); }

#define XB_TMO      128
#define XB_XCNT(j)  (256  + 64 * (j))
#define XB_XSUB(j)  (1280 + 64 * (j))
#define XB_XGEN(j)  (2304 + 64 * (j))
#define XB_TOP      3328
#define XB_TOPGEN   3392
#define XCD_BAR_WORDS 3456
#define XB_SPIN_CAP (1u << 18)

__device__ __forceinline__ unsigned xb_ld(unsigned* p)              { return __hip_atomic_load(p, __ATOMIC_RELAXED, __HIP_MEMORY_SCOPE_AGENT); }
__device__ __forceinline__ unsigned xb_add(unsigned* p, unsigned v) { return __hip_atomic_fetch_add(p, v, __ATOMIC_RELAXED, __HIP_MEMORY_SCOPE_AGENT); }
__device__ __forceinline__ unsigned xb_xcc_id() { return (unsigned)__builtin_amdgcn_s_getreg((3 << 11) | 20) & 0xFu; }
#define XB_SPIN(cond, bar) do { unsigned _sp = 0; while (cond) { __builtin_amdgcn_s_sleep(1); \
    if ((++_sp & 255u) == 0u) { if (xb_ld(&(bar)[XB_TMO])) break; if (_sp > XB_SPIN_CAP) { atomicAdd(&(bar)[XB_TMO], 1u); break; } } } } while (0)

struct XcdBarrier {
    unsigned* bar; unsigned x;
    volatile LAS unsigned* st;
};

__device__ __forceinline__ XcdBarrier xcd_barrier_post(unsigned* bar, volatile LAS unsigned* st) {
    XcdBarrier b; b.bar = bar; b.x = xb_xcc_id(); b.st = st;
    if (threadIdx.x == 0) (void)xb_add(&bar[XB_XCNT(b.x)], 1u);
    return b;
}
__device__ __forceinline__ void xcd_barrier_complete(unsigned* bar, unsigned x, unsigned& nloc, unsigned& nx) {
    const unsigned G = gridDim.x * gridDim.y * gridDim.z;
    unsigned sum, cnt, mine, sp = 0u;
    for (;;) {
        sum = 0u; cnt = 0u; mine = 0u;
#pragma unroll
        for (unsigned j = 0; j < 16; ++j) { const unsigned c = xb_ld(&bar[XB_XCNT(j)]); sum += c; cnt += (c > 0u) ? 1u : 0u; mine = (j == x) ? c : mine; }
        if (sum == G) break;
        __builtin_amdgcn_s_sleep(1);
        if ((++sp & 255u) == 0u) { if (xb_ld(&bar[XB_TMO])) break; if (sp > XB_SPIN_CAP) { atomicAdd(&bar[XB_TMO], 1u); break; } }
    }
    nloc = mine > 0u ? mine : 1u; nx = cnt > 0u ? cnt : 1u;
}

__device__ __forceinline__ void xcd_barrier(const XcdBarrier& b) {
    asm volatile("s_waitcnt vmcnt(0)" ::: "memory");
    __syncthreads();
    if (threadIdx.x == 0) {
        unsigned* bar = b.bar;
        __builtin_amdgcn_s_waitcnt(0);
        unsigned nloc = b.st[0], nx = b.st[1];
        if (nloc == 0u) { xcd_barrier_complete(bar, b.x, nloc, nx); b.st[0] = nloc; b.st[1] = nx; }
        const unsigned old = xb_add(&bar[XB_XSUB(b.x)], 1u);
        const unsigned gen = old / nloc;
        if (old + 1u == (gen + 1u) * nloc) {
            __builtin_amdgcn_fence(__ATOMIC_RELEASE, "agent");
            asm volatile("s_waitcnt vmcnt(0)" ::: "memory");
            const unsigned og = xb_add(&bar[XB_TOP], 1u);
            const unsigned tg = og / nx;
            if (og + 1u == (tg + 1u) * nx) xb_add(&bar[XB_TOPGEN], 1u);
            else XB_SPIN(xb_ld(&bar[XB_TOPGEN]) == tg, bar);
            __builtin_amdgcn_fence(__ATOMIC_ACQUIRE, "agent");
            xb_add(&bar[XB_XGEN(b.x)], 1u);
            asm volatile("s_waitcnt vmcnt(0)" ::: "memory");
        } else {
            XB_SPIN(xb_ld(&bar[XB_XGEN(b.x)]) == gen, bar);
            __builtin_amdgcn_fence(__ATOMIC_ACQUIRE, "agent");
            asm volatile("s_waitcnt vmcnt(0)" ::: "memory");
        }
    }
    __syncthreads();
}
constexpr int DM = 1024, NBATCH = 8, SEQ = 2048, MTOK = NBATCH * SEQ, INC = 12800, DFF = 4096;
constexpr int NWAVES = 8;
constexpr float LOG2E = 1.4426950408889634f;
constexpr size_t MiB = 1u << 20;
constexpr size_t WS_CTL = 0, CTL_ZERO_BYTES = 64 * 1024;
constexpr size_t WS_PART = 1 * MiB;
constexpr size_t WS_ROWP = 1 * MiB, WS_ROWP2 = 2 * MiB;
constexpr size_t WS_MODF = 4 * MiB, WS_BIAS5 = 4 * MiB + 256 * 1024, WS_ABIAS = 4 * MiB + 512 * 1024, WS_ROPE = 5 * MiB;
constexpr size_t WS_WIN = 8 * MiB, WS_WRET = 33 * MiB, WS_WATT = 37 * MiB, WS_WO = 38 * MiB, WS_WFF1 = 40 * MiB, WS_WFF2 = 48 * MiB;
constexpr size_t WS_HB = 56 * MiB;
constexpr size_t WS_R = 88 * MiB;
constexpr size_t WS_ATT = 232 * MiB, WS_GNS = 248 * MiB, WS_END = 256 * MiB;
constexpr size_t DO_LSE = 48 * MiB;
constexpr int CW_BAR = 4096;
constexpr int RING_BYTES = 131072, MISC_OFF = 147456, LDS_BYTES = 151552;

#define GRID_WAVES(F) const int gw = (F).vcu * NWAVES + (F).wave, NGW = (F).G * NWAVES
struct Frame { LAS unsigned char* lds; int tid, lane, wave, vcu, G; };
struct Args { const float* in[16]; float* out; unsigned char* ws; int ph_lo, ph_hi; };

__device__ __forceinline__ float wave_sum(float v) {
#pragma unroll
    for (int o = 1; o < 64; o <<= 1) v += __shfl_xor(v, o);
    return v;
}
__device__ __forceinline__ float wave_max(float v) {
#pragma unroll
    for (int o = 1; o < 64; o <<= 1) v = fmaxf(v, __shfl_xor(v, o));
    return v;
}
__device__ __forceinline__ float bf2f(bf16 h) { return __uint_as_float((unsigned)h << 16); }
__device__ __forceinline__ float bflo(unsigned w) { return __uint_as_float(w << 16); }
__device__ __forceinline__ float bfhi(unsigned w) { return __uint_as_float(w & 0xffff0000u); }
__device__ __forceinline__ int t5_bucket(int dist) {
    if (dist < 16) return dist;
    return 16 + (dist >= 22) + (dist >= 30) + (dist >= 40) + (dist >= 54) + (dist >= 73) + (dist >= 99) + (dist >= 134) + (dist >= 182) + (dist >= 246) + (dist >= 332)
         + (dist >= 450) + (dist >= 609) + (dist >= 825) + (dist >= 1117) + (dist >= 1513);
}

__device__ __forceinline__ void p0_transpose_item(const float* W, int K, int N, bf16* WT, LAS float* scr, int item, int lane) {
    const int nblk = N / 32, kb = item / nblk, nb = item % nblk, k0 = 64 * kb, n0 = 32 * nb;
#pragma unroll 8
    for (int i = 0; i < 32; ++i) { const int kk = 2 * i + (lane >> 5); scr[kk * 33 + (lane & 31)] = W[(size_t)(k0 + kk) * N + n0 + (lane & 31)]; }
    LDS_WAIT(); asm volatile("" ::: "memory");
    const int c = lane & 7;
#pragma unroll
    for (int j = 0; j < 4; ++j) { const int n = (lane >> 3) + 8 * j; const LAS float* s = scr + (8 * c) * 33 + n;
        v4u o; o.x = pk2(s[0 * 33], s[1 * 33]); o.y = pk2(s[2 * 33], s[3 * 33]); o.z = pk2(s[4 * 33], s[5 * 33]); o.w = pk2(s[6 * 33], s[7 * 33]);
        *(GAS v4u*)(WT + (size_t)(n0 + n) * K + k0 + 8 * c) = o; }
    LDS_WAIT(); asm volatile("" ::: "memory");
}
__device__ __forceinline__ void phase_p0(const Frame& F, const Args& a) {
    LAS float* scr = (LAS float*)(F.lds + F.wave * 16384);
    GRID_WAVES(F);
    unsigned char* ws = a.ws;
    constexpr int I_IN = 16 * 400, I_RET = 32 * 32, I_ATT = 8 * 32, I_O = 16 * 32, I_F1 = 16 * 128, I_F2 = 64 * 32, I_T = I_IN + I_RET + I_ATT + I_O + I_F1 + I_F2;
    constexpr int I_ADA = 96 * 16;
    for (int it = gw; it < I_T + I_ADA; it += NGW) {
        int r = it;
        if (r < I_ADA) {
            const int cgp = r % 96, ks = r / 96, n = cgp * 64 + F.lane;
            const float* c = a.in[1]; const float* w = a.in[2];
            float sv[8], acc[8];
#pragma unroll
            for (int b = 0; b < 8; ++b) { const float cv = c[b * DM + ks * 64 + F.lane]; sv[b] = cv / (1.0f + __expf(-cv)); acc[b] = 0.f; }
            for (int kk = 0; kk < 64; ++kk) { const float wv = w[(size_t)(ks * 64 + kk) * 6144 + n];
#pragma unroll
                for (int b = 0; b < 8; ++b) acc[b] = fmaf(__int_as_float(__builtin_amdgcn_readlane(__float_as_int(sv[b]), kk)), wv, acc[b]); }
            float* part = (float*)(ws + WS_PART);
#pragma unroll
            for (int b = 0; b < 8; ++b) part[(size_t)(ks * 8 + b) * 6144 + n] = acc[b];
            continue;
        }
        r -= I_ADA;
        if (r < I_IN) { p0_transpose_item(a.in[5], DM, INC, (bf16*)(ws + WS_WIN), scr, r, F.lane); continue; } r -= I_IN;
        if (r < I_RET) { p0_transpose_item(a.in[9], 2048, DM, (bf16*)(ws + WS_WRET), scr, r, F.lane); continue; } r -= I_RET;
        if (r < I_ATT) { p0_transpose_item(a.in[10], 512, DM, (bf16*)(ws + WS_WATT), scr, r, F.lane); continue; } r -= I_ATT;
        if (r < I_O) { p0_transpose_item(a.in[11], DM, DM, (bf16*)(ws + WS_WO), scr, r, F.lane); continue; } r -= I_O;
        if (r < I_F1) { p0_transpose_item(a.in[13], DM, DFF, (bf16*)(ws + WS_WFF1), scr, r, F.lane); continue; } r -= I_F1;
        p0_transpose_item(a.in[14], DFF, DM, (bf16*)(ws + WS_WFF2), scr, r, F.lane);
    }
    float2* rope = (float2*)(ws + WS_ROPE);
    for (int idx = (F.vcu * NWAVES + F.wave) * 64 + F.lane; idx < SEQ * 128; idx += F.G * NWAVES * 64) {
        const int pos = idx >> 7, i = idx & 127;
        const float inv = powf(10000.0f, -(float)i / 128.0f), ang = (float)pos * inv;
        rope[idx] = make_float2(cosf(ang), sinf(ang));
    }
    if (F.vcu == F.G - 1) {
        float* ab = (float*)(ws + WS_ABIAS); const float* rel = a.in[6];
        for (int idx = F.tid; idx < 12 * 132; idx += NWAVES * 64) { const int gh = idx / 132, m = idx % 132, g = gh >> 2;
            ab[idx] = (m <= 128) ? rel[t5_bucket(m << (2 * g)) * 12 + gh] * LOG2E : 0.f; }
    }
}
__device__ __forceinline__ void phase_p1(const Frame& F, const Args& a) {
    unsigned char* ws = a.ws; const float* part = (const float*)(ws + WS_PART); const float* b_ada = a.in[3];
    float* modf = (float*)(ws + WS_MODF);
    for (int it = F.vcu; it < 48; it += F.G) {
        const int b = it / 6, ch = it % 6;
        for (int col = F.tid; col < 1024; col += NWAVES * 64) { const int n = ch * 1024 + col; float s = b_ada[n];
#pragma unroll
            for (int ks = 0; ks < 16; ++ks) s += part[(size_t)(ks * 8 + b) * 6144 + n];
            modf[b * 6144 + n] = s; }
    }
    LAS float* sh1 = (LAS float*)F.lds; LAS float* g1c = sh1 + 1024;
    const float* x = a.in[0]; const float* n1g = a.in[4]; bf16* hb = (bf16*)(ws + WS_HB);
    for (int rb = F.vcu; rb < MTOK / 64; rb += F.G) {
        const int b = rb >> 5;
        __syncthreads();
        for (int col = F.tid; col < 1024; col += NWAVES * 64) { float s0 = b_ada[col], s1 = b_ada[1024 + col];
#pragma unroll
            for (int ks = 0; ks < 16; ++ks) { s0 += part[(size_t)(ks * 8 + b) * 6144 + col]; s1 += part[(size_t)(ks * 8 + b) * 6144 + 1024 + col]; }
            sh1[col] = s0; g1c[col] = n1g[col] * (1.0f + s1); }
        __syncthreads();
        for (int rr = 0; rr < 8; ++rr) {
            const int row = rb * 64 + F.wave * 8 + rr;
            const GAS f32x4* xr = (const GAS f32x4*)(x + (size_t)row * DM) + F.lane;
            f32x4 v[4]; float s = 0.f;
#pragma unroll
            for (int j = 0; j < 4; ++j) { v[j] = xr[64 * j]; s += (v[j].x * v[j].x + v[j].y * v[j].y) + (v[j].z * v[j].z + v[j].w * v[j].w); }
            const float rstd = 1.0f / sqrtf(wave_sum(s) * (1.f / DM) + 1e-6f);
            GAS unsigned long long* o8 = (GAS unsigned long long*)(hb + (size_t)row * DM) + F.lane;
#pragma unroll
            for (int j = 0; j < 4; ++j) { const int c = 4 * F.lane + 256 * j; const f32x4 g = *(const LAS f32x4*)(g1c + c), sf = *(const LAS f32x4*)(sh1 + c);
                const f32x4 o = v[j] * rstd * g + sf;
                o8[64 * j] = (unsigned long long)pk2(o.x, o.y) | ((unsigned long long)pk2(o.z, o.w) << 32); }
        }
    }
    __syncthreads();
}
__device__ __forceinline__ void phase_attn_naive(const Frame& F, const Args& a) {
    GRID_WAVES(F);
    LAS float* qs = (LAS float*)(F.lds + F.wave * 2048); LAS float* ps = qs + 128;
    const float* abias = (const float*)(a.ws + WS_ABIAS);
    for (int item = gw; item < MTOK * 12; item += NGW) {
        const int gh = item / MTOK, row = item % MTOK, g = gh >> 2, h = gh & 3, sh = 2 * g, dil = 1 << sh, tq = row & 2047, p = tq >> sh;
        const bf16* Q = (const bf16*)(a.ws + WS_R + (size_t)(3 * g + 0) * 16 * MiB); const bf16* K = (const bf16*)(a.ws + WS_R + (size_t)(3 * g + 1) * 16 * MiB); const bf16* V = (const bf16*)(a.ws + WS_R + (size_t)(3 * g + 2) * 16 * MiB);
        const unsigned qw = *(const unsigned*)(Q + (size_t)row * 512 + h * 128 + 2 * F.lane);
        qs[2 * F.lane] = bflo(qw); qs[2 * F.lane + 1] = bfhi(qw);
        LDS_WAIT(); asm volatile("" ::: "memory");
        float sc[3];
#pragma unroll
        for (int u = 0; u < 3; ++u) {
            const int m = F.lane + 64 * u; float s = -1e30f;
            if (m <= 128 && p - m >= 0) {
                const v4u* kr = (const v4u*)(K + (size_t)(row - m * dil) * 512 + h * 128); float acc = 0.f;
                for (int c = 0; c < 16; ++c) { const v4u w = kr[c]; const LAS float* q8 = qs + 8 * c;
                    acc += bflo(w.x) * q8[0] + bfhi(w.x) * q8[1] + bflo(w.y) * q8[2] + bfhi(w.y) * q8[3] + bflo(w.z) * q8[4] + bfhi(w.z) * q8[5] + bflo(w.w) * q8[6] + bfhi(w.w) * q8[7]; }
                s = acc + abias[gh * 132 + m];
            }
            sc[u] = s;
        }
        const float mx = wave_max(fmaxf(sc[0], fmaxf(sc[1], sc[2])));
        float den = 0.f;
#pragma unroll
        for (int u = 0; u < 3; ++u) { const int m = F.lane + 64 * u; const float e = (sc[u] > -1e29f) ? __builtin_amdgcn_exp2f(sc[u] - mx) : 0.f; if (m < 132) ps[m] = e; den += e; }
        den = wave_sum(den);
        LDS_WAIT(); asm volatile("" ::: "memory");
        const int mmax = p < 128 ? p : 128; float a0 = 0.f, a1 = 0.f;
        for (int m = 0; m <= mmax; ++m) { const unsigned vw = *(const unsigned*)(V + (size_t)(row - m * dil) * 512 + h * 128 + 2 * F.lane); const float pv = ps[m]; a0 += pv * bflo(vw); a1 += pv * bfhi(vw); }
        const float inv = 1.0f / den;
        bf16* og = (bf16*)((unsigned char*)a.out + (size_t)g * 16 * MiB);
        *(unsigned*)(og + (size_t)row * 512 + h * 128 + 2 * F.lane) = pk2(a0 * inv, a1 * inv);
        if (F.lane == 0) ((float*)((unsigned char*)a.out + DO_LSE))[((size_t)g * MTOK + row) * 4 + h] = mx + __builtin_log2f(den);
        LDS_WAIT(); asm volatile("" ::: "memory");
    }
}
typedef unsigned u32x4_t __attribute__((ext_vector_type(4)));
typedef float f32x2c_t __attribute__((ext_vector_type(2))); typedef __bf16 bf16x2c_t __attribute__((ext_vector_type(2)));
__device__ __forceinline__ unsigned pk2c(float lo, float hi) { f32x2c_t v = {lo, hi}; bf16x2c_t b = __builtin_convertvector(v, bf16x2c_t); return __builtin_bit_cast(unsigned, b); }
typedef short s16x4_t __attribute__((ext_vector_type(4)));
__device__ __forceinline__ unsigned off_b(unsigned row, unsigned ch) { return 256u * row + 16u * (ch ^ (((row & 3u) << 2) | ((row >> 2) & 3u))); }
__device__ __forceinline__ s16x4_t lds_tr16(LAS unsigned char* p) { return __builtin_bit_cast(s16x4_t, __builtin_amdgcn_ds_read_tr16_b64_v4i16((LAS s16x4_t*)p)); }
__device__ __forceinline__ void phase_attn(const Frame& F, const Args& a) {
    LAS unsigned char* Kimg = F.lds; LAS unsigned char* Vimg = F.lds + 65536; LAS float* bt = (LAS float*)(F.lds + MISC_OFF + 256);
    const float* abias = (const float*)(a.ws + WS_ABIAS);
    const int lane = F.lane, w = F.wave, l15 = lane & 15, g4 = lane >> 4;
    for (int u = F.vcu; u < 1536; u += F.G) {
        const int g = u >> 9, rem = u & 511, b = rem >> 6, h = (rem >> 4) & 3, blk = rem & 15, sh = 2 * g, nbl = 16 >> sh, r = blk / nbl, n = blk % nbl;
        const bf16* Q = (const bf16*)(a.ws + WS_R + (size_t)(3 * g + 0) * 16 * MiB) + h * 128; const bf16* K = (const bf16*)(a.ws + WS_R + (size_t)(3 * g + 1) * 16 * MiB) + h * 128;
        const bf16* V = (const bf16*)(a.ws + WS_R + (size_t)(3 * g + 2) * 16 * MiB) + h * 128;
        const size_t rowb = (size_t)b * SEQ;
        __syncthreads();
        {
            const int ch = F.tid & 15, rb = F.tid >> 4, i0 = (n == 0) ? 4 : 0;
            v4u kr[8], vr[8];
#pragma unroll
            for (int i = 0; i < 8; ++i) if (i >= i0) { const int kj = rb + 32 * i; const size_t row = rowb + (size_t)((((n - 1) * 128 + kj) << sh) + r);
                kr[i] = *(const v4u*)(K + row * 512 + ch * 8); vr[i] = *(const v4u*)(V + row * 512 + ch * 8); }
#pragma unroll
            for (int i = 0; i < 8; ++i) if (i >= i0) { const unsigned o = off_b((unsigned)(rb + 32 * i), (unsigned)ch);
                *(LAS v4u*)(Kimg + o) = kr[i]; *(LAS v4u*)(Vimg + o) = vr[i]; }
            if (F.tid < 132) bt[F.tid] = abias[(g * 4 + h) * 132 + F.tid];
        }
        __syncthreads();
        const int qi = 16 * w + l15; const size_t qrow = rowb + (size_t)(((n * 128 + qi) << sh) + r);
        bf16x8 qf[4];
#pragma unroll
        for (int ks = 0; ks < 4; ++ks) qf[ks] = *(const bf16x8*)(Q + qrow * 512 + 32 * ks + 8 * g4);
        f32x4 O[8];
#pragma unroll
        for (int eb = 0; eb < 8; ++eb) O[eb] = (f32x4){0.f, 0.f, 0.f, 0.f};
        float m_run = -1e30f, l_run = 0.f;
        const int c_lo = (n == 0) ? 4 : (w >> 1), c_hi = (w >> 1) + 4;
        const unsigned trq = (unsigned)(l15 >> 2), trp = (unsigned)(lane & 3);
        for (int c = c_lo; c <= c_hi; ++c) {
            f32x4 sA = (f32x4){0.f, 0.f, 0.f, 0.f}, sB = (f32x4){0.f, 0.f, 0.f, 0.f};
#pragma unroll
            for (int ks = 0; ks < 4; ++ks) {
                const bf16x8 ka = *(const LAS bf16x8*)(Kimg + off_b((unsigned)(32 * c + l15), (unsigned)(4 * ks + g4)));
                const bf16x8 kb = *(const LAS bf16x8*)(Kimg + off_b((unsigned)(32 * c + 16 + l15), (unsigned)(4 * ks + g4)));
                sA = __builtin_amdgcn_mfma_f32_16x16x32_bf16(ka, qf[ks], sA, 0, 0, 0);
                sB = __builtin_amdgcn_mfma_f32_16x16x32_bf16(kb, qf[ks], sB, 0, 0, 0);
            }
            const int mA0 = 128 + qi - (32 * c + 4 * g4);
            float tmax = -1e30f;
#pragma unroll
            for (int rg = 0; rg < 4; ++rg) {
                const int ma = mA0 - rg, mb = ma - 16;
                const float ba = bt[ma < 0 ? 0 : (ma > 128 ? 128 : ma)], bb = bt[mb < 0 ? 0 : (mb > 128 ? 128 : mb)];
                sA[rg] = (ma >= 0 && ma <= 128) ? sA[rg] + ba : -1e30f;
                sB[rg] = (mb >= 0 && mb <= 128) ? sB[rg] + bb : -1e30f;
                tmax = fmaxf(tmax, fmaxf(sA[rg], sB[rg]));
            }
            tmax = fmaxf(tmax, __shfl_xor(tmax, 16)); tmax = fmaxf(tmax, __shfl_xor(tmax, 32));
            const float m_new = fmaxf(m_run, tmax), alpha = __builtin_amdgcn_exp2f(m_run - m_new);
            float psum = 0.f;
#pragma unroll
            for (int rg = 0; rg < 4; ++rg) { sA[rg] = __builtin_amdgcn_exp2f(sA[rg] - m_new); sB[rg] = __builtin_amdgcn_exp2f(sB[rg] - m_new); psum += sA[rg] + sB[rg]; }
            l_run = l_run * alpha + psum; m_run = m_new;
            u32x4_t pw; pw.x = pk2c(sA[0], sA[1]); pw.y = pk2c(sA[2], sA[3]); pw.z = pk2c(sB[0], sB[1]); pw.w = pk2c(sB[2], sB[3]);
            const bf16x8 pf = __builtin_bit_cast(bf16x8, pw);
            const unsigned r0 = (unsigned)(32 * c + 4 * g4) + trq;
#pragma unroll
            for (int eb = 0; eb < 8; ++eb) {
                const s16x4_t v0 = lds_tr16(Vimg + off_b(r0, (unsigned)(2 * eb) + (trp >> 1)) + 8 * (trp & 1));
                const s16x4_t v1 = lds_tr16(Vimg + off_b(r0 + 16, (unsigned)(2 * eb) + (trp >> 1)) + 8 * (trp & 1));
                const bf16x8 vf = (bf16x8){v0[0], v0[1], v0[2], v0[3], v1[0], v1[1], v1[2], v1[3]};
                O[eb] = O[eb] * alpha;
                O[eb] = __builtin_amdgcn_mfma_f32_16x16x32_bf16(vf, pf, O[eb], 0, 0, 0);
            }
        }
        float l = l_run; l += __shfl_xor(l, 16); l += __shfl_xor(l, 32);
        const float inv = 1.0f / l;
        bf16* og = (bf16*)((unsigned char*)a.out + (size_t)g * 16 * MiB) + qrow * 512 + h * 128 + 4 * g4;
#pragma unroll
        for (int eb = 0; eb < 8; ++eb) { const unsigned lo = pk2c(O[eb][0] * inv, O[eb][1] * inv), hi = pk2c(O[eb][2] * inv, O[eb][3] * inv);
            *(unsigned long long*)(og + 16 * eb) = (unsigned long long)lo | ((unsigned long long)hi << 32); }
        if (g4 == 0) ((float*)((unsigned char*)a.out + DO_LSE))[((size_t)g * MTOK + qrow) * 4 + h] = m_run + __builtin_log2f(l);
    }
    __syncthreads();
}
__device__ __forceinline__ void phase_merge(const Frame& F, const Args& a) {
    GRID_WAVES(F);
    const float* lse = (const float*)((unsigned char*)a.out + DO_LSE); bf16* att = (bf16*)(a.ws + WS_ATT);
    for (int row = gw; row < MTOK; row += NGW) {
        const int h = F.lane >> 4; float l[3], mx = -1e30f;
#pragma unroll
        for (int g = 0; g < 3; ++g) { l[g] = lse[((size_t)g * MTOK + row) * 4 + h]; mx = fmaxf(mx, l[g]); }
        float w[3], ws_ = 0.f;
#pragma unroll
        for (int g = 0; g < 3; ++g) { w[g] = __builtin_amdgcn_exp2f(l[g] - mx); ws_ += w[g]; }
        const float inv = 1.0f / ws_; float o[8];
#pragma unroll
        for (int j = 0; j < 8; ++j) o[j] = 0.f;
#pragma unroll
        for (int g = 0; g < 3; ++g) { const v4u v = *(const v4u*)((const bf16*)((unsigned char*)a.out + (size_t)g * 16 * MiB) + (size_t)row * 512 + F.lane * 8); const float wg = w[g] * inv;
            o[0] += wg * bflo(v.x); o[1] += wg * bfhi(v.x); o[2] += wg * bflo(v.y); o[3] += wg * bfhi(v.y); o[4] += wg * bflo(v.z); o[5] += wg * bfhi(v.z); o[6] += wg * bflo(v.w); o[7] += wg * bfhi(v.w); }
        v4u r; r.x = pk2(o[0], o[1]); r.y = pk2(o[2], o[3]); r.z = pk2(o[4], o[5]); r.w = pk2(o[6], o[7]);
        *(v4u*)(att + (size_t)row * 512 + F.lane * 8) = r;
    }
    const float* modf = (const float*)(a.ws + WS_MODF); const bf16* w1t = (const bf16*)(a.ws + WS_WFF1); float* bias5 = (float*)(a.ws + WS_BIAS5);
    for (int n = gw; n < DFF; n += NGW) {
        float wv[16];
        { const v4u w0 = *(const v4u*)(w1t + (size_t)n * DM + 16 * F.lane), w1 = *(const v4u*)(w1t + (size_t)n * DM + 16 * F.lane + 8);
          wv[0] = bflo(w0.x); wv[1] = bfhi(w0.x); wv[2] = bflo(w0.y); wv[3] = bfhi(w0.y); wv[4] = bflo(w0.z); wv[5] = bfhi(w0.z); wv[6] = bflo(w0.w); wv[7] = bfhi(w0.w);
          wv[8] = bflo(w1.x); wv[9] = bfhi(w1.x); wv[10] = bflo(w1.y); wv[11] = bfhi(w1.y); wv[12] = bflo(w1.z); wv[13] = bfhi(w1.z); wv[14] = bflo(w1.w); wv[15] = bfhi(w1.w); }
        for (int b = 0; b < 8; ++b) { const f32x4* sp = (const f32x4*)(modf + b * 6144 + 3 * 1024 + 16 * F.lane); float s = 0.f;
#pragma unroll
            for (int q = 0; q < 4; ++q) { const f32x4 sv = sp[q]; s += sv.x * wv[4 * q] + sv.y * wv[4 * q + 1] + sv.z * wv[4 * q + 2] + sv.w * wv[4 * q + 3]; }
            s = wave_sum(s);
            if (F.lane == 0) bias5[b * 4096 + n] = s; }
    }
}
__device__ __forceinline__ void phase_ret_naive(const Frame& F, const Args& a) {
    LAS float* qs = (LAS float*)F.lds; LAS float* ks = qs + 256; LAS float* red = ks + 256;
    const bf16* RQ = (const bf16*)a.out; const bf16* RK = (const bf16*)((unsigned char*)a.out + 32 * MiB); bf16* RV = (bf16*)(a.ws + WS_R);
    float2* gns = (float2*)(a.ws + WS_GNS);
    for (int u = F.vcu; u < 256; u += F.G) {
        const int b = u >> 5, h = (u >> 3) & 3, es = u & 7, e = F.tid & 63, dg = F.tid >> 6;
        const float lg = __builtin_log2f(1.0f - __builtin_amdgcn_exp2f(-5.0f - (float)h)), cd = __builtin_amdgcn_exp2f(128.0f * lg);
        float T[32];
#pragma unroll
        for (int i = 0; i < 32; ++i) T[i] = 0.f;
        for (int s = 0; s < SEQ; ++s) {
            const size_t row = (size_t)b * SEQ + s;
            __syncthreads();
            if (F.tid < 256) qs[F.tid] = bf2f(RQ[row * 1024 + h * 256 + F.tid]); else ks[F.tid - 256] = bf2f(RK[row * 1024 + h * 256 + F.tid - 256]);
            const float vv = bf2f(RV[row * 2048 + h * 512 + es * 64 + e]);
            __syncthreads();
            float part = 0.f;
#pragma unroll
            for (int i = 0; i < 32; ++i) { const int d = dg * 32 + i; T[i] = fmaf(ks[d], vv, T[i]); part = fmaf(qs[d], T[i], part); }
            red[dg * 64 + e] = part;
            __syncthreads();
            if (F.tid < 64) { float o = 0.f;
#pragma unroll
                for (int j = 0; j < 8; ++j) o += red[j * 64 + F.tid];
                RV[row * 2048 + h * 512 + es * 64 + F.tid] = (bf16)pk2(o, 0.f);
                const float s1 = wave_sum(o), s2 = wave_sum(o * o);
                if (F.tid == 0) { gns[(row * 4 + h) * 16 + es * 2] = make_float2(s1, s2); gns[(row * 4 + h) * 16 + es * 2 + 1] = make_float2(0.f, 0.f); } }
            if ((s & 127) == 127) {
#pragma unroll
                for (int i = 0; i < 32; ++i) T[i] *= cd; }
        }
    }
    __syncthreads();
}
typedef float f32x16_t __attribute__((ext_vector_type(16)));
constexpr int RL_QH = 0, RL_KH = 32768, RL_V = 65536, RL_P = 81920, RL_ST = 114688;
__device__ __forceinline__ unsigned off_v(unsigned row, unsigned ch) { return 128u * row + 16u * (ch ^ ((row & 2u) << 1)); }
__device__ __forceinline__ unsigned off_st(unsigned row, unsigned ch) { return 512u * row + 16u * (ch ^ (row & 15u)); }
__device__ __forceinline__ bf16x8 ret_vfrag(LAS unsigned char* L, int ks, int sub, int h5, unsigned trq, unsigned trp, unsigned trb) {
    const unsigned r0 = (unsigned)(16 * ks + 8 * h5) + trq, chv = (unsigned)(4 * sub) + 2 * trb + (trp >> 1);
    const s16x4_t t0 = lds_tr16(L + RL_V + off_v(r0, chv) + 8 * (trp & 1)), t1 = lds_tr16(L + RL_V + off_v(r0 + 4, chv) + 8 * (trp & 1));
    return (bf16x8){t0[0], t0[1], t0[2], t0[3], t1[0], t1[1], t1[2], t1[3]};
}
__device__ __forceinline__ void phase_ret(const Frame& F, const Args& a) {
    LAS unsigned char* L = F.lds;
    const bf16* RQ = (const bf16*)a.out; const bf16* RK = (const bf16*)((unsigned char*)a.out + 32 * MiB); bf16* RV = (bf16*)(a.ws + WS_R);
    float2* gns = (float2*)(a.ws + WS_GNS);
    const int lane = F.lane, w = F.wave, l31 = lane & 31, h5 = lane >> 5, ib = w >> 1, sub = w & 1;
    const unsigned trq = (unsigned)((lane & 15) >> 2), trp = (unsigned)(lane & 3), trb = (unsigned)((lane >> 4) & 1);
    for (int u = F.vcu; u < 256; u += F.G) {
        const int b = u >> 5, h = (u >> 3) & 3, es = u & 7;
        const float lg = __builtin_log2f(1.0f - __builtin_amdgcn_exp2f(-5.0f - (float)h)), cd = __builtin_amdgcn_exp2f(128.0f * lg);
        const size_t rowb = (size_t)b * SEQ;
        f32x16_t Sst[2];
#pragma unroll
        for (int i = 0; i < 16; ++i) { Sst[0][i] = 0.f; Sst[1][i] = 0.f; }
        __syncthreads();
        for (int i = F.tid; i < 2048; i += NWAVES * 64) *(LAS v4u*)(L + RL_ST + 16 * i) = (v4u){0u, 0u, 0u, 0u};
        for (int c = 0; c < 16; ++c) {
            const size_t row0 = rowb + (size_t)c * 128;
            unsigned oz = 0u; asm volatile("" : "+v"(oz));
            f32x16_t Sacc[2], Oacc;
#pragma unroll
            for (int i = 0; i < 16; ++i) { Sacc[0][i] = 0.f; Sacc[1][i] = 0.f; Oacc[i] = 0.f; }
#pragma unroll
            for (int hh = 0; hh < 2; ++hh) {
                {
                    const int ch = F.tid & 15, rb = F.tid >> 4; v4u qr[4], kr[4];
#pragma unroll
                    for (int i = 0; i < 4; ++i) { const size_t g = (row0 + rb + 32 * i) * 1024 + h * 256 + hh * 128 + ch * 8; qr[i] = *(const v4u*)(RQ + g); kr[i] = *(const v4u*)(RK + g); }
                    v4u vr[2]; const int vch = F.tid & 7, vrb = F.tid >> 3;
                    if (hh == 0) {
#pragma unroll
                        for (int i = 0; i < 2; ++i) vr[i] = *(const v4u*)(RV + (row0 + vrb + 64 * i) * 2048 + h * 512 + es * 64 + vch * 8); }
#pragma unroll
                    for (int i = 0; i < 4; ++i) { const unsigned o = off_b((unsigned)(rb + 32 * i), (unsigned)ch); *(LAS v4u*)(L + RL_QH + o) = qr[i]; *(LAS v4u*)(L + RL_KH + o) = kr[i]; }
                    if (hh == 0) {
#pragma unroll
                        for (int i = 0; i < 2; ++i) *(LAS v4u*)(L + RL_V + off_v((unsigned)(vrb + 64 * i), (unsigned)vch)) = vr[i]; }
                }
                __syncthreads();
#pragma unroll
                for (int s = 0; s < 8; ++s) {
                    const bf16x8 qf = *(const LAS bf16x8*)(L + RL_QH + off_b((unsigned)(32 * ib + l31) + oz, (unsigned)(2 * s + h5)));
#pragma unroll
                    for (int jj = 0; jj < 2; ++jj) { const int jb = 2 * sub + jj;
                        if (jb <= ib) { const bf16x8 kf = *(const LAS bf16x8*)(L + RL_KH + off_b((unsigned)(32 * jb + l31) + oz, (unsigned)(2 * s + h5)));
                            Sacc[jj] = __builtin_amdgcn_mfma_f32_32x32x16_bf16(kf, qf, Sacc[jj], 0, 0, 0); } }
                    const bf16x8 sf = *(const LAS bf16x8*)(L + RL_ST + off_st((unsigned)(32 * sub + l31) + oz, (unsigned)(16 * hh + 2 * s + h5)));
                    Oacc = __builtin_amdgcn_mfma_f32_32x32x16_bf16(qf, sf, Oacc, 0, 0, 0);
                }
#pragma unroll
                for (int ks = 0; ks < 8; ++ks) { const unsigned r0 = (unsigned)(16 * ks + 8 * h5) + trq, chk = (unsigned)(4 * ib) + 2 * trb + (trp >> 1);
                    const s16x4_t t0 = lds_tr16(L + RL_KH + off_b(r0, chk) + 8 * (trp & 1)), t1 = lds_tr16(L + RL_KH + off_b(r0 + 4, chk) + 8 * (trp & 1));
                    const bf16x8 kt = (bf16x8){t0[0], t0[1], t0[2], t0[3], t1[0], t1[1], t1[2], t1[3]};
                    Sst[hh] = __builtin_amdgcn_mfma_f32_32x32x16_bf16(kt, ret_vfrag(L, ks, sub, h5, trq, trp, trb), Sst[hh], 0, 0, 0); }
#pragma unroll
                for (int i = 0; i < 16; ++i) Sst[hh][i] *= cd;
                if (hh == 1) {
#pragma unroll
                    for (int jj = 0; jj < 2; ++jj) { const int jb = 2 * sub + jj;
                        if (jb <= ib) {
#pragma unroll
                            for (int rg = 0; rg < 4; ++rg) { float p[4];
#pragma unroll
                                for (int e = 0; e < 4; ++e) { const int jin = 8 * rg + 4 * h5 + e; p[e] = (jb < ib || jin <= l31) ? Sacc[jj][4 * rg + e] : 0.f; }
                                *(LAS unsigned long long*)(L + RL_P + off_b((unsigned)(32 * ib + l31), (unsigned)(4 * jb + rg)) + 8 * h5) = (unsigned long long)pk2c(p[0], p[1]) | ((unsigned long long)pk2c(p[2], p[3]) << 32); } } }
                }
                __syncthreads();
#pragma unroll
                for (int rg = 0; rg < 4; ++rg)
                    *(LAS unsigned long long*)(L + RL_ST + off_st((unsigned)(32 * sub + l31), (unsigned)(16 * hh + 4 * ib + rg)) + 8 * h5) =
                        (unsigned long long)pk2c(Sst[hh][4 * rg], Sst[hh][4 * rg + 1]) | ((unsigned long long)pk2c(Sst[hh][4 * rg + 2], Sst[hh][4 * rg + 3]) << 32);
            }
#pragma unroll
            for (int s = 0; s < 8; ++s) if (s < 2 * (ib + 1)) { const bf16x8 pf = *(const LAS bf16x8*)(L + RL_P + off_b((unsigned)(32 * ib + l31), (unsigned)(2 * s + h5)));
                Oacc = __builtin_amdgcn_mfma_f32_32x32x16_bf16(pf, ret_vfrag(L, s, sub, h5, trq, trp, trb), Oacc, 0, 0, 0); }
            bf16* op = RV + (row0 + 32 * ib + 4 * h5) * 2048 + h * 512 + es * 64 + 32 * sub + l31;
#pragma unroll
            for (int rg = 0; rg < 4; ++rg)
#pragma unroll
                for (int e = 0; e < 4; ++e) { const float o = Oacc[4 * rg + e]; const int ir = 8 * rg + e;
                    op[(size_t)ir * 2048] = (bf16)pk2c(o, 0.f);
                    float s1 = o, s2 = o * o;
#pragma unroll
                    for (int sh = 1; sh < 32; sh <<= 1) { s1 += __shfl_xor(s1, sh); s2 += __shfl_xor(s2, sh); }
                    if (l31 == 0) gns[((row0 + 32 * ib + 4 * h5 + ir) * 4 + h) * 16 + es * 2 + sub] = make_float2(s1, s2); }
            __syncthreads();
        }
    }
}
__device__ __forceinline__ void phase_gn(const Frame& F, const Args& a) {
    GRID_WAVES(F);
    const float2* gns = (const float2*)(a.ws + WS_GNS); const bf16* ro = (const bf16*)(a.ws + WS_R); bf16* sg = (bf16*)(a.ws + WS_R + 64 * MiB);
    const float* gg = a.in[7]; const float* gb = a.in[8];
    for (int row = gw; row < MTOK; row += NGW) {
        const float2 st = gns[(size_t)row * 64 + F.lane]; float s1 = st.x, s2 = st.y;
#pragma unroll
        for (int o = 1; o < 16; o <<= 1) { s1 += __shfl_xor(s1, o); s2 += __shfl_xor(s2, o); }
        const float mu = s1 * (1.0f / 512.0f), var = fmaxf(s2 * (1.0f / 512.0f) - mu * mu, 0.f), rstd = 1.0f / sqrtf(var + 1e-5f);
#pragma unroll
        for (int c = 0; c < 4; ++c) {
            const float muh = __shfl(mu, 16 * c), rsh = __shfl(rstd, 16 * c); const int col = (F.lane + 64 * c) * 8;
            const v4u rv = *(const v4u*)(ro + (size_t)row * 2048 + col), gv = *(const v4u*)(sg + (size_t)row * 2048 + col);
            const f32x4 g0 = *(const f32x4*)(gg + col), g1 = *(const f32x4*)(gg + col + 4), b0 = *(const f32x4*)(gb + col), b1 = *(const f32x4*)(gb + col + 4);
            float o[8]; const float r[8] = {bflo(rv.x), bfhi(rv.x), bflo(rv.y), bfhi(rv.y), bflo(rv.z), bfhi(rv.z), bflo(rv.w), bfhi(rv.w)};
            const float s[8] = {bflo(gv.x), bfhi(gv.x), bflo(gv.y), bfhi(gv.y), bflo(gv.z), bfhi(gv.z), bflo(gv.w), bfhi(gv.w)};
            const float gq[8] = {g0.x, g0.y, g0.z, g0.w, g1.x, g1.y, g1.z, g1.w}, bq[8] = {b0.x, b0.y, b0.z, b0.w, b1.x, b1.y, b1.z, b1.w};
#pragma unroll
            for (int j = 0; j < 8; ++j) o[j] = s[j] * ((r[j] - muh) * rsh * gq[j] + bq[j]);
            v4u w; w.x = pk2(o[0], o[1]); w.y = pk2(o[2], o[3]); w.z = pk2(o[4], o[5]); w.w = pk2(o[6], o[7]);
            *(v4u*)(sg + (size_t)row * 2048 + col) = w;
        }
    }
}
__device__ __forceinline__ void phase_final(const Frame& F, const Args& a) {
    GRID_WAVES(F);
    const float* rowp = (const float*)(a.ws + WS_ROWP2); const float* gf = a.in[15];
    for (int row = gw; row < MTOK; row += NGW) {
        float s = (F.lane < 16) ? rowp[(size_t)row * 16 + F.lane] : 0.f;
        s = wave_sum(s);
        const float rstd = 1.0f / sqrtf(s * (1.0f / DM) + 1e-6f);
        GAS f32x4* xr = (GAS f32x4*)(a.out + (size_t)row * DM) + F.lane;
#pragma unroll
        for (int j = 0; j < 4; ++j) { const f32x4 g = *(const f32x4*)(gf + 4 * F.lane + 256 * j); xr[64 * j] = xr[64 * j] * rstd * g; }
    }
}
#ifndef MK_PER_PHASE
#define MK_PER_PHASE 0
#endif
constexpr int N_PHASES = 15;
__global__ void __launch_bounds__(NWAVES * 64, 2) mega_fwd(Args args) {
    extern __shared__ __attribute__((aligned(16))) unsigned char lds_raw[];
    Frame F;
    F.lds = (LAS unsigned char*)lds_raw;
    F.tid = threadIdx.x; F.lane = F.tid & 63; F.wave = __builtin_amdgcn_readfirstlane(F.tid >> 6);
    F.G = gridDim.x; { const int bx = blockIdx.x; F.vcu = (F.G % 8 == 0) ? (bx % 8) * (F.G / 8) + bx / 8 : bx; }
    volatile LAS unsigned* MISC = (volatile LAS unsigned*)(F.lds + MISC_OFF);
    if (F.tid < 64) MISC[F.tid] = 0u;
    __syncthreads();
    unsigned char* ws = args.ws; unsigned char* dob = (unsigned char*)args.out;
    cg::grid_group grid = cg::this_grid();
    XcdBarrier bar; bar.bar = (unsigned*)(ws + WS_CTL) + CW_BAR; bar.x = 0; bar.st = nullptr;
    if (!MK_PER_PHASE) bar = xcd_barrier_post((unsigned*)(ws + WS_CTL) + CW_BAR, MISC + 8);
    const int lo = args.ph_lo, hi = args.ph_hi;
#define IN(k) (lo <= (k) && (k) < hi)
#define SEAM(k) do { if (IN(k) && IN((k) + 1)) { if ((k) == 0) grid.sync(); else xcd_barrier(bar); } } while (0)
    typedef pg8::bf16_t b16;
    b16* HB = (b16*)(ws + WS_HB); const b16* WIN = (const b16*)(ws + WS_WIN);
    const float* modf = (const float*)(ws + WS_MODF);

    if (IN(0)) { phase_p0(F, args); } SEAM(0);
    if (IN(1)) { phase_p1(F, args); } SEAM(1);
    if (IN(2)) {
        pg8::Gemm g{HB, WIN + (size_t)6144 * DM, MTOK, 4608, DM}; pg8::StaticOrder S; S.init(MTOK, 4608, F.G, (int)blockIdx.x);
        pg8::EpiProj<0> E{(b16*)(ws + WS_R), nullptr, nullptr, nullptr, nullptr};
        pg8::gemm_phase<pg8::EpiProj<0>, pg8::StaticOrder, true, true>(F.lds, g, S, E);
    } SEAM(2);
    if (IN(3)) { phase_attn(F, args); } SEAM(3);
    if (IN(4)) { phase_merge(F, args); } SEAM(4);
    if (IN(5)) {
        pg8::Gemm g{HB, WIN, MTOK, 6144, DM}; pg8::StaticOrder S; S.init(MTOK, 6144, F.G, (int)blockIdx.x);
        pg8::EpiProj<1> E{(b16*)dob, (b16*)(dob + 32 * MiB), (b16*)(ws + WS_R), (b16*)(ws + WS_R + 64 * MiB), (const float*)(ws + WS_ROPE)};
        pg8::gemm_phase<pg8::EpiProj<1>, pg8::StaticOrder, true, true>(F.lds, g, S, E);
    } SEAM(5);
    if (IN(6)) { phase_ret(F, args); } SEAM(6);
    if (IN(7)) { phase_gn(F, args); } SEAM(7);
    if (IN(8)) {
        pg8::Gemm g{HB, WIN + (size_t)10752 * DM, MTOK, 2048, DM}; pg8::StaticOrder S; S.init(MTOK, 2048, F.G, (int)blockIdx.x);
        pg8::EpiProj<2> E{(b16*)(dob + 32 * MiB), (b16*)(ws + WS_R), nullptr, nullptr, nullptr};
        pg8::gemm_phase<pg8::EpiProj<2>, pg8::StaticOrder, true, true>(F.lds, g, S, E);
    } SEAM(8);
    if (IN(9)) {
        pg8::Gemm g{(const b16*)(ws + WS_ATT), (const b16*)(ws + WS_WATT), MTOK, DM, 512}; pg8::StaticOrder S; S.init(MTOK, DM, F.G, (int)blockIdx.x);
        pg8::EpiT3 E{(const b16*)(ws + WS_R), (b16*)dob};
        pg8::gemm_phase<pg8::EpiT3, pg8::StaticOrder, true, true>(F.lds, g, S, E);
    }
    if (IN(10)) {
        pg8::Gemm g{(const b16*)(ws + WS_R + 64 * MiB), (const b16*)(ws + WS_WRET), MTOK, DM, 2048}; pg8::StaticOrder S; S.init(MTOK, DM, F.G, (int)blockIdx.x);
        pg8::EpiMerged E{(const b16*)(dob + 32 * MiB), (const b16*)dob, (b16*)(ws + WS_R + 32 * MiB)};
        pg8::gemm_phase<pg8::EpiMerged, pg8::StaticOrder, true, true>(F.lds, g, S, E);
    } SEAM(10);
    if (IN(11)) {
        pg8::Gemm g{(const b16*)(ws + WS_R + 32 * MiB), (const b16*)(ws + WS_WO), MTOK, DM, DM}; pg8::StaticOrder S; S.init(MTOK, DM, F.G, (int)blockIdx.x);
        pg8::EpiX1 E{args.in[0], modf, args.in[12], args.out, HB, (float*)(ws + WS_ROWP)};
        pg8::gemm_phase<pg8::EpiX1, pg8::StaticOrder, true, true>(F.lds, g, S, E);
    } SEAM(11);
    if (IN(12)) {
        pg8::Gemm g{HB, (const b16*)(ws + WS_WFF1), MTOK, DFF, DM}; pg8::StaticOrder S; S.init(MTOK, DFF, F.G, (int)blockIdx.x);
        pg8::EpiFF1 E{(const float*)(ws + WS_ROWP), (const float*)(ws + WS_BIAS5), (b16*)(ws + WS_R)};
        pg8::gemm_phase<pg8::EpiFF1, pg8::StaticOrder, true, true>(F.lds, g, S, E);
    } SEAM(12);
    if (IN(13)) {
        pg8::Gemm g{(const b16*)(ws + WS_R), (const b16*)(ws + WS_WFF2), MTOK, DM, DFF}; pg8::StaticOrder S; S.init(MTOK, DM, F.G, (int)blockIdx.x);
        pg8::EpiX2 E{modf, args.out, (float*)(ws + WS_ROWP2)};
        pg8::gemm_phase<pg8::EpiX2, pg8::StaticOrder, true, true>(F.lds, g, S, E);
    } SEAM(13);
    if (IN(14)) { phase_final(F, args); }
#undef IN
#undef SEAM
}


extern "C" void kernel_launch(void* const* d_in, const int* in_sizes, int n_in, void* d_out, int out_size, void* d_ws, size_t ws_size, hipStream_t stream) {
    static int grid = 0;
    if (grid == 0) {
        if (n_in != 16 || out_size != MTOK * DM || ws_size < WS_END) { fprintf(stderr, "kernel_launch: unexpected shapes (n_in %d out %d ws %zu)\n", n_in, out_size, ws_size); grid = -1; return; }
        int dev = 0, cus = 0, per_cu = 0;
        (void)hipGetDevice(&dev); (void)hipDeviceGetAttribute(&cus, hipDeviceAttributeMultiprocessorCount, dev);
        if (hipFuncSetAttribute((const void*)mega_fwd, hipFuncAttributeMaxDynamicSharedMemorySize, LDS_BYTES) != hipSuccess) { fprintf(stderr, "kernel_launch: hipFuncSetAttribute failed\n"); grid = -1; return; }
        if (hipOccupancyMaxActiveBlocksPerMultiprocessor(&per_cu, (const void*)mega_fwd, NWAVES * 64, LDS_BYTES) != hipSuccess || per_cu < 1) { fprintf(stderr, "kernel_launch: occupancy query says %d\n", per_cu); (void)hipGetLastError(); per_cu = 1; }
        grid = cus;
        if (grid != 256) fprintf(stderr, "kernel_launch: %d CUs; the phase program assumes 256\n", grid);
    }
    if (grid < 0) return;
    (void)hipMemsetAsync((char*)d_ws + WS_CTL, 0, CTL_ZERO_BYTES, stream);
    Args a{};
    for (int i = 0; i < 16; ++i) a.in[i] = (const float*)d_in[i];
    a.out = (float*)d_out; a.ws = (unsigned char*)d_ws;
#if MK_PER_PHASE
    for (int p = 0; p < N_PHASES; ++p) { a.ph_lo = p; a.ph_hi = p + 1; hipLaunchKernelGGL(mega_fwd, dim3(grid), dim3(NWAVES * 64), LDS_BYTES, stream, a); }
#else
    a.ph_lo = 0; a.ph_hi = N_PHASES;
    void* kargs[] = {&a};
    const hipError_t e = hipLaunchCooperativeKernel((const void*)mega_fwd, dim3(grid), dim3(NWAVES * 64), kargs, LDS_BYTES, stream);
    if (e != hipSuccess) fprintf(stderr, "kernel_launch: cooperative launch failed: %s (grid %d)\n", hipGetErrorString(e), grid);
#endif
}
```

```cpp
#include <hip/hip_runtime.h>
#include <hip/hip_cooperative_groups.h>
#include <cstdio>
#include <cstdint>
namespace cg = cooperative_groups;
namespace pg8 {
#define PG8_LAS __attribute__((address_space(3)))
typedef unsigned short bf16_t;
typedef short bf16x8 __attribute__((ext_vector_type(8)));
typedef float f32x4 __attribute__((ext_vector_type(4)));
typedef unsigned u32x4 __attribute__((ext_vector_type(4)));
constexpr int BM = 256, BK = 64, HALF = 128, HTB = HALF * BK * 2  , STAGE_BYTES = 8 * HTB, NXCD = 8, WGM = 8;

__host__ __device__ __forceinline__ int lds_byte(int r, int c) { const int st = (r >> 4) * 2 + (c >> 5), rr = r & 15, cc = c & 31, ob = rr * 64 + cc * 2; return st * 1024 + (ob ^ (((ob >> 9) & 1) << 5)); }
__host__ __device__ __forceinline__ void stage_rc(int b, int& R, int& C) { const int st = b / 1024, sb = b % 1024, swz = sb ^ (((sb >> 9) & 1) << 5); R = (st >> 1) * 16 + swz / 64; C = (st & 1) * 32 + (swz % 64) / 2; }
__host__ __device__ __forceinline__ int perm32(int rho) { const int n = rho >> 4, i = rho & 15; return 8 * (i >> 2) + 4 * n + (i & 3); }

struct Unit { int pm, pn; };
struct Gemm { const bf16_t* A; const bf16_t* Bt; int M, N, K; int split_tile; size_t split_extra; };

struct StaticOrder {
    int nM, nN, nwg, G, c;
    __host__ __device__ void init(int M, int N, int G_, int c_) { nM = M / BM; nN = N / BM; nwg = nM * nN; G = G_; c = c_; }
    __host__ __device__ bool next(int i, Unit& u) const {
        const long L = (long)i * G + c; if (L >= nwg) return false;
        int wgid = (int)L; { const int q = nwg / NXCD, r = nwg % NXCD, xcd = wgid % NXCD, off = wgid / NXCD; wgid = (xcd < r ? xcd * (q + 1) : r * (q + 1) + (xcd - r) * q) + off; }
        const int nig = WGM * nN, gid = wgid / nig, fm = gid * WGM, gsz = (nM - fm) < WGM ? (nM - fm) : WGM;
        u.pm = fm + ((wgid % nig) % gsz); u.pn = (wgid % nig) / gsz; return true;
    }
    __device__ __forceinline__ void a_ready(const Unit&) const {}
    __device__ __forceinline__ void done(const Unit&) const {}
};

typedef float f32x2_t __attribute__((ext_vector_type(2))); typedef __bf16 bf16x2_t __attribute__((ext_vector_type(2)));
__device__ __forceinline__ unsigned cvt_pk_bf16(float lo, float hi) { f32x2_t v = {lo, hi}; bf16x2_t b = __builtin_convertvector(v, bf16x2_t); return __builtin_bit_cast(unsigned, b); }
__device__ __forceinline__ void st8(bf16_t* p, f32x4 a, f32x4 b) { u32x4 w; w.x = cvt_pk_bf16(a[0], a[1]); w.y = cvt_pk_bf16(a[2], a[3]); w.z = cvt_pk_bf16(b[0], b[1]); w.w = cvt_pk_bf16(b[2], b[3]); *(u32x4*)p = w; }
__device__ __forceinline__ float bfl(unsigned w) { return __uint_as_float(w << 16); }
__device__ __forceinline__ float bfh(unsigned w) { return __uint_as_float(w & 0xffff0000u); }
__device__ __forceinline__ void ld8(const bf16_t* p, f32x4& a, f32x4& b) { const u32x4 w = *(const u32x4*)p; a = (f32x4){bfl(w.x), bfh(w.x), bfl(w.y), bfh(w.y)}; b = (f32x4){bfl(w.z), bfh(w.z), bfl(w.w), bfh(w.w)}; }
__device__ __forceinline__ f32x4 sigmoid4(f32x4 v) { f32x4 o;
#pragma unroll
    for (int j = 0; j < 4; ++j) o[j] = __builtin_amdgcn_rcpf(1.f + __builtin_amdgcn_exp2f(-1.4426950408889634f * v[j])); return o; }

constexpr float QSCALE = 0.08838834764831845f * 1.4426950408889634f;
constexpr size_t MiB_ = 1u << 20;

template <int PASS> struct EpiProj {
    static constexpr bool PERM = true, AFTER_DRAIN = false;
    bf16_t* d0; bf16_t* d1; bf16_t* d2; bf16_t* d3; const float* rope; const float* gns; const float* gng; const float* gnb;
    __device__ __forceinline__ void operator()(const f32x4 (&acc)[2][2][4][2], const Unit& u, int wr, int wc, int fr, int fq) const {
        const int row0 = u.pm * BM + wr * 64 + fr, cl0 = wc * 32 + 8 * fq, pn = __builtin_amdgcn_readfirstlane(u.pn);
        if (PASS == 0) {
            const int part = pn >> 1; bf16_t* base = d0 + (size_t)part * (8 * MiB_) + (pn & 1) * 256 + cl0;
            const float sc = (part % 3 == 0) ? QSCALE : 1.0f;
#pragma unroll
            for (int ai = 0; ai < 2; ++ai)
#pragma unroll
                for (int m = 0; m < 4; ++m) { bf16_t* rp = base + (size_t)(row0 + ai * HALF + m * 16) * 512;
#pragma unroll
                    for (int bj = 0; bj < 2; ++bj) st8(rp + bj * HALF, acc[ai][bj][m][0] * sc, acc[ai][bj][m][1] * sc); }
        } else if (PASS == 1) {
            if (pn < 8) {
                const int head = pn & 3; const bool isk = pn >= 4; bf16_t* base = (isk ? d1 : d0) + head * 256 + cl0;
                const float lg = __builtin_log2f(1.0f - __builtin_amdgcn_exp2f(-5.0f - (float)head));
#pragma unroll
                for (int ai = 0; ai < 2; ++ai)
#pragma unroll
                    for (int m = 0; m < 4; ++m) { const int row = row0 + ai * HALF + m * 16, pos = row & 2047, ci = pos & 127;
                        const float e = (float)(ci + 1) * lg; const float sc = isk ? 0.0625f * __builtin_amdgcn_exp2f(-e) : __builtin_amdgcn_exp2f(e);
                        const f32x4* rp = (const f32x4*)(rope + ((size_t)pos * 128 + cl0) * 2);
                        f32x4 o1[2], o2[2];
#pragma unroll
                        for (int n = 0; n < 2; ++n) { const f32x4 ra = rp[2 * n], rb = rp[2 * n + 1]; const f32x4 x1 = acc[ai][0][m][n], x2 = acc[ai][1][m][n];
                            const f32x4 cs = (f32x4){ra[0], ra[2], rb[0], rb[2]}, sn = (f32x4){ra[1], ra[3], rb[1], rb[3]};
                            o1[n] = (x1 * cs - x2 * sn) * sc; o2[n] = (x1 * sn + x2 * cs) * sc; }
                        bf16_t* dp = base + (size_t)row * 1024; st8(dp, o1[0], o1[1]); st8(dp + HALF, o2[0], o2[1]); }
            } else {
                bf16_t* base = d2 + (pn - 8) * 256 + cl0;
#pragma unroll
                for (int ai = 0; ai < 2; ++ai)
#pragma unroll
                    for (int m = 0; m < 4; ++m) { bf16_t* rp = base + (size_t)(row0 + ai * HALF + m * 16) * 2048;
#pragma unroll
                        for (int bj = 0; bj < 2; ++bj) st8(rp + bj * HALF, acc[ai][bj][m][0], acc[ai][bj][m][1]); }
            }
        } else {
            if (PASS == 2) {
                const int head = pn >> 1, colh = head * 512 + (pn & 1) * 256 + cl0;
#pragma unroll
                for (int ai = 0; ai < 2; ++ai)
#pragma unroll
                    for (int m = 0; m < 4; ++m) { const int row = row0 + ai * HALF + m * 16;
                        const f32x4* sp = (const f32x4*)(gns + ((size_t)row * 4 + head) * 32 + 8 * fq);
                        const f32x4 sa_ = sp[0], sb_ = sp[1]; float s1 = (sa_[0] + sa_[2]) + (sb_[0] + sb_[2]), s2 = (sa_[1] + sa_[3]) + (sb_[1] + sb_[3]);
                        s1 += __shfl_xor(s1, 16); s1 += __shfl_xor(s1, 32); s2 += __shfl_xor(s2, 16); s2 += __shfl_xor(s2, 32);
                        const float mu = s1 * (1.0f / 512.0f), var = fmaxf(s2 * (1.0f / 512.0f) - mu * mu, 0.f), rstd = __builtin_amdgcn_rsqf(var + 1e-5f);
#pragma unroll
                        for (int bj = 0; bj < 2; ++bj)
#pragma unroll
                            for (int n = 0; n < 2; ++n) { int c = colh + bj * HALF + 4 * n; asm volatile("" : "+v"(c));
                                const unsigned long long rw = *(const unsigned long long*)(d2 + (size_t)row * 2048 + c); const unsigned r0 = (unsigned)rw, r1 = (unsigned)(rw >> 32);
                                const f32x4 rv = (f32x4){bfl(r0), bfh(r0), bfl(r1), bfh(r1)}, gq = *(const f32x4*)(gng + c), bq = *(const f32x4*)(gnb + c), a = acc[ai][bj][m][n];
                                const f32x4 o = a * sigmoid4(a) * ((rv - mu) * rstd * gq + bq);
                                *(unsigned long long*)(d3 + (size_t)row * 2048 + c) = (unsigned long long)cvt_pk_bf16(o[0], o[1]) | ((unsigned long long)cvt_pk_bf16(o[2], o[3]) << 32); }
                        asm volatile("" ::: "memory"); }
            } else {
                const int q = pn; bf16_t* base = (q >= 4 ? d1 : d0) + (q & 3) * 256 + cl0;
#pragma unroll
                for (int ai = 0; ai < 2; ++ai)
#pragma unroll
                    for (int m = 0; m < 4; ++m) { bf16_t* rp = base + (size_t)(row0 + ai * HALF + m * 16) * 1024;
#pragma unroll
                        for (int bj = 0; bj < 2; ++bj) st8(rp + bj * HALF, sigmoid4(acc[ai][bj][m][0]), sigmoid4(acc[ai][bj][m][1])); }
            }
        }
    }
};
struct GateOrder { Unit base;
    __device__ bool next(int i, Unit& u) const { if (i >= 2) return false; u.pm = base.pm; u.pn = base.pn + 4 * i; return true; }
    __device__ __forceinline__ void a_ready(const Unit&) const {}
    __device__ __forceinline__ void done(const Unit&) const {} };
struct EpiT3 { static constexpr bool PERM = true, AFTER_DRAIN = false; const bf16_t* sb; bf16_t* t3;
    __device__ __forceinline__ void operator()(const f32x4 (&acc)[2][2][4][2], const Unit& u, int wr, int wc, int fr, int fq) const {
        const int row0 = u.pm * BM + wr * 64 + fr, col0 = u.pn * BM + wc * 32 + 8 * fq;
#pragma unroll
        for (int ai = 0; ai < 2; ++ai)
#pragma unroll
            for (int m = 0; m < 4; ++m) { const size_t off = (size_t)(row0 + ai * HALF + m * 16) * 1024 + col0;
#pragma unroll
                for (int bj = 0; bj < 2; ++bj) { f32x4 ga, gb; ld8(sb + off + bj * HALF, ga, gb); st8(t3 + off + bj * HALF, acc[ai][bj][m][0] * ga, acc[ai][bj][m][1] * gb); } }
    } };
struct EpiMerged { static constexpr bool PERM = true, AFTER_DRAIN = false; const bf16_t* sa; const bf16_t* t3; bf16_t* mg;
    __device__ __forceinline__ void operator()(const f32x4 (&acc)[2][2][4][2], const Unit& u, int wr, int wc, int fr, int fq) const {
        const int row0 = u.pm * BM + wr * 64 + fr, col0 = u.pn * BM + wc * 32 + 8 * fq;
#pragma unroll
        for (int ai = 0; ai < 2; ++ai)
#pragma unroll
            for (int m = 0; m < 4; ++m) { const size_t off = (size_t)(row0 + ai * HALF + m * 16) * 1024 + col0;
#pragma unroll
                for (int bj = 0; bj < 2; ++bj) { f32x4 ga, gb, ta, tb; ld8(sa + off + bj * HALF, ga, gb); ld8(t3 + off + bj * HALF, ta, tb);
                    st8(mg + off + bj * HALF, acc[ai][bj][m][0] * ga + ta, acc[ai][bj][m][1] * gb + tb); } }
    } };
struct EpiX1 { static constexpr bool PERM = true, AFTER_DRAIN = false; const float* x; const float* modf; const float* n2g; float* x1; bf16_t* a5; float* rowp;
    __device__ __forceinline__ void operator()(const f32x4 (&acc)[2][2][4][2], const Unit& u, int wr, int wc, int fr, int fq) const {
        const int row0 = u.pm * BM + wr * 64 + fr, col0 = u.pn * BM + wc * 32 + 8 * fq, b = (u.pm * BM) >> 11;
        f32x4 g1[2][2], gg[2][2];
#pragma unroll
        for (int bj = 0; bj < 2; ++bj)
#pragma unroll
            for (int n = 0; n < 2; ++n) { const int c = col0 + bj * HALF + 4 * n; g1[bj][n] = *(const f32x4*)(modf + b * 6144 + 2 * 1024 + c);
                gg[bj][n] = *(const f32x4*)(n2g + c) * (*(const f32x4*)(modf + b * 6144 + 4 * 1024 + c) + 1.0f); }
#pragma unroll
        for (int ai = 0; ai < 2; ++ai)
#pragma unroll
            for (int m = 0; m < 4; ++m) { const int row = row0 + ai * HALF + m * 16; const size_t off = (size_t)row * 1024 + col0; float ss = 0.f;
#pragma unroll
                for (int bj = 0; bj < 2; ++bj) { f32x4 v[2];
#pragma unroll
                    for (int n = 0; n < 2; ++n) { v[n] = *(const f32x4*)(x + off + bj * HALF + 4 * n) + g1[bj][n] * acc[ai][bj][m][n]; *(f32x4*)(x1 + off + bj * HALF + 4 * n) = v[n];
                        ss += (v[n][0] * v[n][0] + v[n][1] * v[n][1]) + (v[n][2] * v[n][2] + v[n][3] * v[n][3]); }
                    st8(a5 + off + bj * HALF, v[0] * gg[bj][0], v[1] * gg[bj][1]); }
                ss += __shfl_xor(ss, 16); ss += __shfl_xor(ss, 32);
                if (fq == 0) rowp[(size_t)row * 16 + u.pn * 4 + wc] = ss; }
    } };
struct EpiFF1 { static constexpr bool PERM = true, AFTER_DRAIN = false; const float* rowp; const float* bias5; bf16_t* uo;
    __device__ __forceinline__ void operator()(const f32x4 (&acc)[2][2][4][2], const Unit& u, int wr, int wc, int fr, int fq) const {
        const int row0 = u.pm * BM + wr * 64 + fr, col0 = u.pn * BM + wc * 32 + 8 * fq, b = (u.pm * BM) >> 11;
        f32x4 bs[2][2];
#pragma unroll
        for (int bj = 0; bj < 2; ++bj)
#pragma unroll
            for (int n = 0; n < 2; ++n) bs[bj][n] = *(const f32x4*)(bias5 + b * 4096 + col0 + bj * HALF + 4 * n);
#pragma unroll
        for (int ai = 0; ai < 2; ++ai)
#pragma unroll
            for (int m = 0; m < 4; ++m) { const int row = row0 + ai * HALF + m * 16; const f32x4* rp = (const f32x4*)(rowp + (size_t)row * 16);
                const f32x4 s4 = (rp[0] + rp[1]) + (rp[2] + rp[3]); const float rstd = __builtin_amdgcn_rsqf(((s4[0] + s4[1]) + (s4[2] + s4[3])) * (1.0f / 1024.0f) + 1e-6f);
#pragma unroll
                for (int bj = 0; bj < 2; ++bj) { f32x4 v[2];
#pragma unroll
                    for (int n = 0; n < 2; ++n) { v[n] = acc[ai][bj][m][n] * rstd + bs[bj][n];
#pragma unroll
                        for (int j = 0; j < 4; ++j) { const float r = v[n][j] > 0.f ? v[n][j] : 0.f; v[n][j] = r * r; } }
                    st8(uo + (size_t)row * 4096 + col0 + bj * HALF, v[0], v[1]); } }
    } };
struct EpiX2 { static constexpr bool PERM = true, AFTER_DRAIN = false; const float* modf; float* x1; float* rowp;
    __device__ __forceinline__ void operator()(const f32x4 (&acc)[2][2][4][2], const Unit& u, int wr, int wc, int fr, int fq) const {
        const int row0 = u.pm * BM + wr * 64 + fr, col0 = u.pn * BM + wc * 32 + 8 * fq, b = (u.pm * BM) >> 11;
        f32x4 g2[2][2];
#pragma unroll
        for (int bj = 0; bj < 2; ++bj)
#pragma unroll
            for (int n = 0; n < 2; ++n) g2[bj][n] = *(const f32x4*)(modf + b * 6144 + 5 * 1024 + col0 + bj * HALF + 4 * n);
#pragma unroll
        for (int ai = 0; ai < 2; ++ai)
#pragma unroll
            for (int m = 0; m < 4; ++m) { const int row = row0 + ai * HALF + m * 16; const size_t off = (size_t)row * 1024 + col0; float ss = 0.f;
#pragma unroll
                for (int bj = 0; bj < 2; ++bj)
#pragma unroll
                    for (int n = 0; n < 2; ++n) { float* p = x1 + off + bj * HALF + 4 * n; const f32x4 v = *(const f32x4*)p + g2[bj][n] * acc[ai][bj][m][n]; *(f32x4*)p = v;
                        ss += (v[0] * v[0] + v[1] * v[1]) + (v[2] * v[2] + v[3] * v[3]); }
                ss += __shfl_xor(ss, 16); ss += __shfl_xor(ss, 32);
                if (fq == 0) rowp[(size_t)row * 16 + u.pn * 4 + wc] = ss; }
    } };
template <class Epi, class Sched, bool ALIGN_EPI = false, bool SP2 = false>
__device__ __forceinline__ void gemm_phase(PG8_LAS unsigned char* lds, const Gemm g, const Sched& S, const Epi& E) {
    const int tid = threadIdx.x, wid = __builtin_amdgcn_readfirstlane(tid >> 6), lane = tid & 63, wr = wid >> 2, wc = wid & 3, fr = lane & 15, fq = lane >> 4;
    const int K = g.K, nt = K / BK;
    unsigned voffA[2], voffB[2];
#pragma unroll
    for (int i = 0; i < 2; ++i) { int R, C; stage_rc(tid * 16 + i * 8192, R, C); const int Rb = Epi::PERM ? ((R & ~31) + perm32(R & 31)) : R;
        voffA[i] = (unsigned)(R * K + C) * 2u; voffB[i] = (unsigned)(Rb * K + C) * 2u; }
    const size_t kstep = (size_t)(BK * 2);
    const size_t hstep = (size_t)HALF * K * 2;
    const size_t tstep = 2 * hstep;
    const unsigned ldsw = (unsigned)wid * 1024u;
    const int aoff = lds_byte(wr * 64 + fr, fq * 8), boff = lds_byte(wc * 32 + fr, fq * 8);
#define PG8_SA(b, h) (((b) * 2 + (h)) * HTB)
#define PG8_SB(b, h) ((4 + (b) * 2 + (h)) * HTB)
#define PG8_STAGE(bufoff, gbase, voff) do { _Pragma("unroll") for (int _i = 0; _i < 2; ++_i) \
        __builtin_amdgcn_global_load_lds((const unsigned*)((const char*)(gbase) + (voff)[_i]), (PG8_LAS unsigned*)(lds + (bufoff) + ldsw + _i * 8192), 16, 0, 0); } while (0)
#define PG8_LDA(dst, b, h) do { _Pragma("unroll") for (int m = 0; m < 4; ++m) _Pragma("unroll") for (int k = 0; k < 2; ++k) dst[m][k] = *(const PG8_LAS bf16x8*)(lds + PG8_SA(b, h) + aoff + m * 2048 + k * 1024); } while (0)
#define PG8_LDB(dst, b, h) do { _Pragma("unroll") for (int n = 0; n < 2; ++n) _Pragma("unroll") for (int k = 0; k < 2; ++k) dst[n][k] = *(const PG8_LAS bf16x8*)(lds + PG8_SB(b, h) + boff + n * 2048 + k * 1024); } while (0)
#define PG8_MMA(ai, bj, At, Bt) do { __builtin_amdgcn_s_setprio(1); _Pragma("unroll") for (int m = 0; m < 4; ++m) _Pragma("unroll") for (int n = 0; n < 2; ++n) _Pragma("unroll") for (int k = 0; k < 2; ++k) \
        acc[ai][bj][m][n] = __builtin_amdgcn_mfma_f32_16x16x32_bf16(Bt[n][k], At[m][k], acc[ai][bj][m][n], 0, 0, 0); __builtin_amdgcn_s_setprio(0); } while (0)
#define PG8_WAIT_V(n) asm volatile("s_waitcnt vmcnt(" #n ")" ::: "memory")
#define PG8_WAIT_L(n) asm volatile("s_waitcnt lgkmcnt(" #n ")" ::: "memory")
#define PG8_BAR __builtin_amdgcn_s_barrier()
#define PG8_SCHED __builtin_amdgcn_sched_barrier(0)
    Unit cur, nxt; int ui = 0;
    if (!S.next(0, cur)) return;
    f32x4 acc[2][2][4][2];
#pragma unroll
    for (int a = 0; a < 2; ++a)
#pragma unroll
        for (int b = 0; b < 2; ++b)
#pragma unroll
            for (int m = 0; m < 4; ++m)
#pragma unroll
                for (int n = 0; n < 2; ++n) acc[a][b][m][n] = (f32x4){0.f, 0.f, 0.f, 0.f};
    bf16x8 At[4][2], B0[2][2], B1[2][2];
    const char* cA = (const char*)g.A + (size_t)cur.pm * tstep; const char* cB = (const char*)g.Bt + (size_t)cur.pn * tstep + (cur.pn >= g.split_tile ? g.split_extra : (size_t)0);
    S.a_ready(cur);
    if constexpr (SP2) {
        PG8_STAGE(PG8_SB(0, 0), cB, voffB); PG8_STAGE(PG8_SB(0, 1), cB + hstep, voffB); PG8_STAGE(PG8_SA(0, 0), cA, voffA); PG8_STAGE(PG8_SA(0, 1), cA + hstep, voffA);
        if (wr == 1) PG8_BAR;
        PG8_WAIT_V(2); PG8_BAR;
        PG8_STAGE(PG8_SB(1, 0), cB + kstep, voffB); PG8_STAGE(PG8_SA(1, 0), cA + kstep, voffA); PG8_STAGE(PG8_SB(1, 1), cB + hstep + kstep, voffB);
        PG8_WAIT_V(6); PG8_BAR;
    } else {
        PG8_STAGE(PG8_SB(0, 0), cB, voffB); PG8_STAGE(PG8_SA(0, 0), cA, voffA); PG8_STAGE(PG8_SB(0, 1), cB + hstep, voffB); PG8_STAGE(PG8_SA(0, 1), cA + hstep, voffA);
        if (wr == 1) PG8_BAR;
        PG8_WAIT_V(4); PG8_BAR;
        PG8_STAGE(PG8_SB(1, 0), cB + kstep, voffB); PG8_STAGE(PG8_SA(1, 0), cA + kstep, voffA); PG8_STAGE(PG8_SB(1, 1), cB + hstep + kstep, voffB);
        PG8_WAIT_V(6); PG8_BAR;
    }
    for (;;) {
        const bool has_next = S.next(ui + 1, nxt);
        const char* nA = has_next ? (const char*)g.A + (size_t)nxt.pm * tstep : cA; const char* nB = has_next ? (const char*)g.Bt + (size_t)nxt.pn * tstep + (nxt.pn >= g.split_tile ? g.split_extra : (size_t)0) : cB;
        for (int t = 0; t < nt; t += 2) {
            const bool last = (t == nt - 2);
            const char* a1 = cA + (size_t)(t + 1) * kstep;
            const char* a2 = last ? nA : cA + (size_t)(t + 2) * kstep; const char* b2 = last ? nB : cB + (size_t)(t + 2) * kstep;
            const char* a3 = a2 + kstep; const char* b3 = b2 + kstep;
            if (last && has_next) S.a_ready(nxt);
            if constexpr (SP2) {
            PG8_LDB(B0, 0, 0); PG8_LDB(B1, 0, 1); PG8_SCHED; PG8_LDA(At, 0, 0); PG8_STAGE(PG8_SA(1, 1), a1 + hstep, voffA);
            PG8_WAIT_V(8); PG8_WAIT_L(0); PG8_BAR; PG8_MMA(0, 0, At, B0); PG8_MMA(0, 1, At, B1); PG8_BAR; PG8_SCHED;
            PG8_LDA(At, 0, 1); PG8_STAGE(PG8_SB(0, 0), b2, voffB); PG8_STAGE(PG8_SB(0, 1), b2 + hstep, voffB); PG8_STAGE(PG8_SA(0, 0), a2, voffA);
            PG8_WAIT_V(8); PG8_WAIT_L(0); PG8_BAR; PG8_MMA(1, 0, At, B0); PG8_MMA(1, 1, At, B1); PG8_BAR; PG8_SCHED;
            PG8_LDB(B0, 1, 0); PG8_LDB(B1, 1, 1); PG8_SCHED; PG8_LDA(At, 1, 0); PG8_STAGE(PG8_SA(0, 1), a2 + hstep, voffA);
            PG8_WAIT_V(8); PG8_WAIT_L(0); PG8_BAR; PG8_MMA(0, 0, At, B0); PG8_MMA(0, 1, At, B1); PG8_BAR; PG8_SCHED;
            PG8_LDA(At, 1, 1); PG8_STAGE(PG8_SB(1, 0), b3, voffB); PG8_STAGE(PG8_SB(1, 1), b3 + hstep, voffB); PG8_STAGE(PG8_SA(1, 0), a3, voffA);
            PG8_WAIT_V(8); PG8_WAIT_L(0); PG8_BAR; PG8_MMA(1, 0, At, B0); PG8_MMA(1, 1, At, B1); PG8_BAR; PG8_SCHED;
            } else {
            PG8_LDB(B0, 0, 0); PG8_SCHED; PG8_LDA(At, 0, 0); PG8_STAGE(PG8_SA(1, 1), a1 + hstep, voffA);
            PG8_WAIT_L(8); PG8_BAR; PG8_WAIT_L(0); PG8_MMA(0, 0, At, B0); PG8_BAR; PG8_SCHED;
            PG8_LDB(B1, 0, 1); PG8_STAGE(PG8_SB(0, 0), b2, voffB);
            PG8_BAR; PG8_WAIT_L(0); PG8_MMA(0, 1, At, B1); PG8_BAR;
            PG8_LDA(At, 0, 1); PG8_STAGE(PG8_SA(0, 0), a2, voffA);
            PG8_BAR; PG8_WAIT_L(0); PG8_MMA(1, 0, At, B0); PG8_BAR; PG8_SCHED;
            PG8_STAGE(PG8_SB(0, 1), b2 + hstep, voffB);
            PG8_WAIT_V(6); PG8_BAR; PG8_MMA(1, 1, At, B1); PG8_BAR;
            PG8_LDB(B0, 1, 0); PG8_SCHED; PG8_LDA(At, 1, 0); PG8_STAGE(PG8_SA(0, 1), a2 + hstep, voffA);
            PG8_WAIT_L(8); PG8_BAR; PG8_WAIT_L(0); PG8_MMA(0, 0, At, B0); PG8_BAR; PG8_SCHED;
            PG8_LDB(B1, 1, 1); PG8_STAGE(PG8_SB(1, 0), b3, voffB);
            PG8_BAR; PG8_WAIT_L(0); PG8_MMA(0, 1, At, B1); PG8_BAR;
            PG8_LDA(At, 1, 1); PG8_STAGE(PG8_SA(1, 0), a3, voffA);
            PG8_BAR; PG8_WAIT_L(0); PG8_MMA(1, 0, At, B0); PG8_BAR; PG8_SCHED;
            PG8_STAGE(PG8_SB(1, 1), b3 + hstep, voffB);
            PG8_WAIT_V(6); PG8_BAR; PG8_MMA(1, 1, At, B1); PG8_BAR;
            }
        }
        if constexpr (ALIGN_EPI) { if (wr == 0) PG8_BAR; }
        if constexpr (!Epi::AFTER_DRAIN) { E(acc, cur, wr, wc, fr, fq); S.done(cur); }
        if (!has_next) break;
#pragma unroll
        for (int a = 0; a < 2; ++a)
#pragma unroll
            for (int b = 0; b < 2; ++b)
#pragma unroll
                for (int m = 0; m < 4; ++m)
#pragma unroll
                    for (int n = 0; n < 2; ++n) acc[a][b][m][n] = (f32x4){0.f, 0.f, 0.f, 0.f};
        cur = nxt; cA = nA; cB = nB; ++ui;
        if constexpr (ALIGN_EPI) { if (wr == 1) PG8_BAR; }
    }
    PG8_WAIT_V(0);
    if constexpr (!ALIGN_EPI) { if (wr == 0) PG8_BAR; }
    PG8_BAR;
    if constexpr (Epi::AFTER_DRAIN) { E.fused(acc, cur, wr, wc, fr, fq, lds, wid, lane); S.done(cur); }
#undef PG8_SA
#undef PG8_SB
#undef PG8_STAGE
#undef PG8_LDA
#undef PG8_LDB
#undef PG8_MMA
#undef PG8_WAIT_V
#undef PG8_WAIT_L
#undef PG8_BAR
#undef PG8_SCHED
}
}
#define GAS __attribute__((address_space(1)))
#define LAS __attribute__((address_space(3)))
typedef unsigned short bf16;
typedef unsigned v4u __attribute__((ext_vector_type(4)));
typedef float f32x4 __attribute__((ext_vector_type(4)));
typedef short bf16x8 __attribute__((ext_vector_type(8)));
typedef GAS unsigned gu32;
typedef GAS unsigned long long gu64;
#define RLX_AGENT __ATOMIC_RELAXED, __HIP_MEMORY_SCOPE_AGENT
#define LDS_WAIT() asm volatile("s_waitcnt lgkmcnt(0)" ::: "memory")
#define VM_WAIT() asm volatile("s_waitcnt vmcnt(0)" ::: "memory")
__device__ __forceinline__ unsigned long long rt() { return __builtin_amdgcn_s_memrealtime(); }
__device__ __forceinline__ unsigned f2bf(float f) { unsigned u = __builtin_bit_cast(unsigned, f); return (u + 0x7fffu + ((u >> 16) & 1u)) >> 16; }
__device__ __forceinline__ unsigned pk2(float lo, float hi) { return f2bf(lo) | (f2bf(hi) << 16); }

#define XB_TMO      128
#define XB_XCNT(j)  (256  + 64 * (j))
#define XB_XSUB(j)  (1280 + 64 * (j))
#define XB_XGEN(j)  (2304 + 64 * (j))
#define XB_TOP      3328
#define XB_TOPGEN   3392
#define XCD_BAR_WORDS 3456
#define XB_SPIN_CAP (1u << 18)

__device__ __forceinline__ unsigned xb_ld(unsigned* p)              { return __hip_atomic_load(p, __ATOMIC_RELAXED, __HIP_MEMORY_SCOPE_AGENT); }
__device__ __forceinline__ unsigned xb_add(unsigned* p, unsigned v) { return __hip_atomic_fetch_add(p, v, __ATOMIC_RELAXED, __HIP_MEMORY_SCOPE_AGENT); }
__device__ __forceinline__ unsigned xb_xcc_id() { return (unsigned)__builtin_amdgcn_s_getreg((3 << 11) | 20) & 0xFu; }
#define XB_SPIN(cond, bar) do { unsigned _sp = 0; while (cond) { __builtin_amdgcn_s_sleep(1); \
    if ((++_sp & 255u) == 0u) { if (xb_ld(&(bar)[XB_TMO])) break; if (_sp > XB_SPIN_CAP) { atomicAdd(&(bar)[XB_TMO], 1u); break; } } } } while (0)

struct XcdBarrier {
    unsigned* bar; unsigned x;
    volatile LAS unsigned* st;
};

__device__ __forceinline__ XcdBarrier xcd_barrier_post(unsigned* bar, volatile LAS unsigned* st) {
    XcdBarrier b; b.bar = bar; b.x = xb_xcc_id(); b.st = st;
    if (threadIdx.x == 0) (void)xb_add(&bar[XB_XCNT(b.x)], 1u);
    return b;
}
__device__ __forceinline__ void xcd_barrier_complete(unsigned* bar, unsigned x, unsigned& nloc, unsigned& nx) {
    const unsigned G = gridDim.x * gridDim.y * gridDim.z;
    unsigned sum, cnt, mine, sp = 0u;
    for (;;) {
        sum = 0u; cnt = 0u; mine = 0u;
#pragma unroll
        for (unsigned j = 0; j < 16; ++j) { const unsigned c = xb_ld(&bar[XB_XCNT(j)]); sum += c; cnt += (c > 0u) ? 1u : 0u; mine = (j == x) ? c : mine; }
        if (sum == G) break;
        __builtin_amdgcn_s_sleep(1);
        if ((++sp & 255u) == 0u) { if (xb_ld(&bar[XB_TMO])) break; if (sp > XB_SPIN_CAP) { atomicAdd(&bar[XB_TMO], 1u); break; } }
    }
    nloc = mine > 0u ? mine : 1u; nx = cnt > 0u ? cnt : 1u;
}

__device__ __forceinline__ void xcd_barrier(const XcdBarrier& b) {
    asm volatile("s_waitcnt vmcnt(0)" ::: "memory");
    __syncthreads();
    if (threadIdx.x == 0) {
        unsigned* bar = b.bar;
        __builtin_amdgcn_s_waitcnt(0);
        unsigned nloc = b.st[0], nx = b.st[1];
        if (nloc == 0u) { xcd_barrier_complete(bar, b.x, nloc, nx); b.st[0] = nloc; b.st[1] = nx; }
        const unsigned old = xb_add(&bar[XB_XSUB(b.x)], 1u);
        const unsigned gen = old / nloc;
        if (old + 1u == (gen + 1u) * nloc) {
            __builtin_amdgcn_fence(__ATOMIC_RELEASE, "agent");
            asm volatile("s_waitcnt vmcnt(0)" ::: "memory");
            const unsigned og = xb_add(&bar[XB_TOP], 1u);
            const unsigned tg = og / nx;
            if (og + 1u == (tg + 1u) * nx) xb_add(&bar[XB_TOPGEN], 1u);
            else XB_SPIN(xb_ld(&bar[XB_TOPGEN]) == tg, bar);
            __builtin_amdgcn_fence(__ATOMIC_ACQUIRE, "agent");
            xb_add(&bar[XB_XGEN(b.x)], 1u);
            asm volatile("s_waitcnt vmcnt(0)" ::: "memory");
        } else {
            XB_SPIN(xb_ld(&bar[XB_XGEN(b.x)]) == gen, bar);
            __builtin_amdgcn_fence(__ATOMIC_ACQUIRE, "agent");
            asm volatile("s_waitcnt vmcnt(0)" ::: "memory");
        }
    }
    __syncthreads();
}
constexpr int DM = 1024, NBATCH = 8, SEQ = 2048, MTOK = NBATCH * SEQ, INC = 12800, DFF = 4096;
constexpr int NWAVES = 8;
constexpr float LOG2E = 1.4426950408889634f;
constexpr size_t MiB = 1u << 20;
constexpr size_t WS_CTL = 0, CTL_ZERO_BYTES = 64 * 1024;
constexpr size_t WS_PART = 1 * MiB;
constexpr size_t WS_ROWP = 1 * MiB, WS_ROWP2 = 2 * MiB;
constexpr size_t WS_MODF = 4 * MiB, WS_BIAS5 = 4 * MiB + 256 * 1024, WS_ABIAS = 4 * MiB + 512 * 1024, WS_ROPE = 5 * MiB;
constexpr size_t WS_WIN = 8 * MiB, WS_WRET = 33 * MiB, WS_WATT = 37 * MiB, WS_WO = 38 * MiB, WS_WFF1 = 40 * MiB, WS_WFF2 = 48 * MiB;
constexpr size_t WS_HB = 56 * MiB;
constexpr size_t WS_R = 88 * MiB;
constexpr size_t WS_ATT = 232 * MiB, WS_GNS = 248 * MiB, WS_END = 256 * MiB;
constexpr size_t WS_LSE = 3 * MiB;
constexpr size_t WS_XBUF = 2 * MiB;
constexpr int CW_BAR = 4096;
constexpr int RING_BYTES = 131072, MISC_OFF = 147456, LDS_BYTES = 151552;

#define GRID_WAVES(F) const int gw = (F).vcu * NWAVES + (F).wave, NGW = (F).G * NWAVES
struct Frame { LAS unsigned char* lds; int tid, lane, wave, vcu, G; };
struct Args { const float* in[16]; float* out; unsigned char* ws; int ph_lo, ph_hi; };

__device__ __forceinline__ float wave_sum(float v) {
#pragma unroll
    for (int o = 1; o < 64; o <<= 1) v += __shfl_xor(v, o);
    return v;
}
__device__ __forceinline__ float wave_max(float v) {
#pragma unroll
    for (int o = 1; o < 64; o <<= 1) v = fmaxf(v, __shfl_xor(v, o));
    return v;
}
__device__ __forceinline__ float bf2f(bf16 h) { return __uint_as_float((unsigned)h << 16); }
__device__ __forceinline__ float bflo(unsigned w) { return __uint_as_float(w << 16); }
__device__ __forceinline__ float bfhi(unsigned w) { return __uint_as_float(w & 0xffff0000u); }
__device__ __forceinline__ int t5_bucket(int dist) {
    if (dist < 16) return dist;
    return 16 + (dist >= 22) + (dist >= 30) + (dist >= 40) + (dist >= 54) + (dist >= 73) + (dist >= 99) + (dist >= 134) + (dist >= 182) + (dist >= 246) + (dist >= 332)
         + (dist >= 450) + (dist >= 609) + (dist >= 825) + (dist >= 1117) + (dist >= 1513);
}

__device__ __forceinline__ void p0_transpose_item(const float* W, int K, int N, bf16* WT, LAS float* scr, int item, int lane) {
    const int nblk = N / 32, kb = item / nblk, nb = item % nblk, k0 = 64 * kb, n0 = 32 * nb;
#pragma unroll 8
    for (int i = 0; i < 32; ++i) { const int kk = 2 * i + (lane >> 5); scr[kk * 33 + (lane & 31)] = W[(size_t)(k0 + kk) * N + n0 + (lane & 31)]; }
    LDS_WAIT(); asm volatile("" ::: "memory");
    const int c = lane & 7;
#pragma unroll
    for (int j = 0; j < 4; ++j) { const int n = (lane >> 3) + 8 * j; const LAS float* s = scr + (8 * c) * 33 + n;
        v4u o; o.x = pk2(s[0 * 33], s[1 * 33]); o.y = pk2(s[2 * 33], s[3 * 33]); o.z = pk2(s[4 * 33], s[5 * 33]); o.w = pk2(s[6 * 33], s[7 * 33]);
        *(GAS v4u*)(WT + (size_t)(n0 + n) * K + k0 + 8 * c) = o; }
    LDS_WAIT(); asm volatile("" ::: "memory");
}
__device__ __forceinline__ void phase_p0(const Frame& F, const Args& a) {
    LAS float* scr = (LAS float*)(F.lds + F.wave * 16384);
    GRID_WAVES(F);
    unsigned char* ws = a.ws;
    constexpr int I_IN = 16 * 400, I_RET = 32 * 32, I_ATT = 8 * 32, I_O = 16 * 32, I_F1 = 16 * 128, I_F2 = 64 * 32, I_T = I_IN + I_RET + I_ATT + I_O + I_F1 + I_F2;
    constexpr int I_ADA = 96 * 16;
    for (int it = gw; it < I_T + I_ADA; it += NGW) {
        int r = it;
        if (r < I_ADA) {
            const int cgp = r % 96, ks = r / 96, n = cgp * 64 + F.lane;
            const float* c = a.in[1]; const float* w = a.in[2];
            float sv[8], acc[8];
#pragma unroll
            for (int b = 0; b < 8; ++b) { const float cv = c[b * DM + ks * 64 + F.lane]; sv[b] = cv / (1.0f + __expf(-cv)); acc[b] = 0.f; }
            for (int kk = 0; kk < 64; ++kk) { const float wv = w[(size_t)(ks * 64 + kk) * 6144 + n];
#pragma unroll
                for (int b = 0; b < 8; ++b) acc[b] = fmaf(__int_as_float(__builtin_amdgcn_readlane(__float_as_int(sv[b]), kk)), wv, acc[b]); }
            float* part = (float*)(ws + WS_PART);
#pragma unroll
            for (int b = 0; b < 8; ++b) part[(size_t)(ks * 8 + b) * 6144 + n] = acc[b];
            continue;
        }
        r -= I_ADA;
        if (r < I_IN) { p0_transpose_item(a.in[5], DM, INC, (bf16*)(ws + WS_WIN), scr, r, F.lane); continue; } r -= I_IN;
        if (r < I_RET) { p0_transpose_item(a.in[9], 2048, DM, (bf16*)(ws + WS_WRET), scr, r, F.lane); continue; } r -= I_RET;
        if (r < I_ATT) { p0_transpose_item(a.in[10], 512, DM, (bf16*)(ws + WS_WATT), scr, r, F.lane); continue; } r -= I_ATT;
        if (r < I_O) { p0_transpose_item(a.in[11], DM, DM, (bf16*)(ws + WS_WO), scr, r, F.lane); continue; } r -= I_O;
        if (r < I_F1) { p0_transpose_item(a.in[13], DM, DFF, (bf16*)(ws + WS_WFF1), scr, r, F.lane); continue; } r -= I_F1;
        p0_transpose_item(a.in[14], DFF, DM, (bf16*)(ws + WS_WFF2), scr, r, F.lane);
    }
    float2* rope = (float2*)(ws + WS_ROPE);
    for (int idx = (F.vcu * NWAVES + F.wave) * 64 + F.lane; idx < SEQ * 128; idx += F.G * NWAVES * 64) {
        const int pos = idx >> 7, i = idx & 127;
        const float inv = powf(10000.0f, -(float)i / 128.0f), ang = (float)pos * inv;
        rope[idx] = make_float2(cosf(ang), sinf(ang));
    }
    if (F.vcu == F.G - 1) {
        float* ab = (float*)(ws + WS_ABIAS); const float* rel = a.in[6];
        for (int idx = F.tid; idx < 12 * 132; idx += NWAVES * 64) { const int gh = idx / 132, m = idx % 132, g = gh >> 2;
            ab[idx] = (m <= 128) ? rel[t5_bucket(m << (2 * g)) * 12 + gh] * LOG2E : 0.f; }
    }
}
__device__ __forceinline__ void phase_p1(const Frame& F, const Args& a) {
    unsigned char* ws = a.ws; const float* part = (const float*)(ws + WS_PART); const float* b_ada = a.in[3];
    float* modf = (float*)(ws + WS_MODF);
    for (int it = F.vcu; it < 48; it += F.G) {
        const int b = it / 6, ch = it % 6;
        for (int col = F.tid; col < 1024; col += NWAVES * 64) { const int n = ch * 1024 + col; float s = b_ada[n];
#pragma unroll
            for (int ks = 0; ks < 16; ++ks) s += part[(size_t)(ks * 8 + b) * 6144 + n];
            modf[b * 6144 + n] = s; }
    }
    LAS float* sh1 = (LAS float*)F.lds; LAS float* g1c = sh1 + 1024;
    const float* x = a.in[0]; const float* n1g = a.in[4]; bf16* hb = (bf16*)(ws + WS_HB);
    for (int rb = F.vcu; rb < MTOK / 64; rb += F.G) {
        const int b = rb >> 5;
        __syncthreads();
        for (int col = F.tid; col < 1024; col += NWAVES * 64) { float s0 = b_ada[col], s1 = b_ada[1024 + col];
#pragma unroll
            for (int ks = 0; ks < 16; ++ks) { s0 += part[(size_t)(ks * 8 + b) * 6144 + col]; s1 += part[(size_t)(ks * 8 + b) * 6144 + 1024 + col]; }
            sh1[col] = s0; g1c[col] = n1g[col] * (1.0f + s1); }
        __syncthreads();
        for (int rr = 0; rr < 8; ++rr) {
            const int row = rb * 64 + F.wave * 8 + rr;
            const GAS f32x4* xr = (const GAS f32x4*)(x + (size_t)row * DM) + F.lane;
            f32x4 v[4]; float s = 0.f;
#pragma unroll
            for (int j = 0; j < 4; ++j) { v[j] = xr[64 * j]; s += (v[j].x * v[j].x + v[j].y * v[j].y) + (v[j].z * v[j].z + v[j].w * v[j].w); }
            const float rstd = 1.0f / sqrtf(wave_sum(s) * (1.f / DM) + 1e-6f);
            GAS unsigned long long* o8 = (GAS unsigned long long*)(hb + (size_t)row * DM) + F.lane;
#pragma unroll
            for (int j = 0; j < 4; ++j) { const int c = 4 * F.lane + 256 * j; const f32x4 g = *(const LAS f32x4*)(g1c + c), sf = *(const LAS f32x4*)(sh1 + c);
                const f32x4 o = v[j] * rstd * g + sf;
                o8[64 * j] = (unsigned long long)pk2(o.x, o.y) | ((unsigned long long)pk2(o.z, o.w) << 32); }
        }
    }
    __syncthreads();
}
__device__ __forceinline__ void phase_attn_naive(const Frame& F, const Args& a) {
    GRID_WAVES(F);
    LAS float* qs = (LAS float*)(F.lds + F.wave * 2048); LAS float* ps = qs + 128;
    const float* abias = (const float*)(a.ws + WS_ABIAS);
    for (int item = gw; item < MTOK * 12; item += NGW) {
        const int gh = item / MTOK, row = item % MTOK, g = gh >> 2, h = gh & 3, sh = 2 * g, dil = 1 << sh, tq = row & 2047, p = tq >> sh;
        const bf16* Q = (const bf16*)(a.ws + WS_R + (size_t)(3 * g + 0) * 16 * MiB); const bf16* K = (const bf16*)(a.ws + WS_R + (size_t)(3 * g + 1) * 16 * MiB); const bf16* V = (const bf16*)(a.ws + WS_R + (size_t)(3 * g + 2) * 16 * MiB);
        const unsigned qw = *(const unsigned*)(Q + (size_t)row * 512 + h * 128 + 2 * F.lane);
        qs[2 * F.lane] = bflo(qw); qs[2 * F.lane + 1] = bfhi(qw);
        LDS_WAIT(); asm volatile("" ::: "memory");
        float sc[3];
#pragma unroll
        for (int u = 0; u < 3; ++u) {
            const int m = F.lane + 64 * u; float s = -1e30f;
            if (m <= 128 && p - m >= 0) {
                const v4u* kr = (const v4u*)(K + (size_t)(row - m * dil) * 512 + h * 128); float acc = 0.f;
                for (int c = 0; c < 16; ++c) { const v4u w = kr[c]; const LAS float* q8 = qs + 8 * c;
                    acc += bflo(w.x) * q8[0] + bfhi(w.x) * q8[1] + bflo(w.y) * q8[2] + bfhi(w.y) * q8[3] + bflo(w.z) * q8[4] + bfhi(w.z) * q8[5] + bflo(w.w) * q8[6] + bfhi(w.w) * q8[7]; }
                s = acc + abias[gh * 132 + m];
            }
            sc[u] = s;
        }
        const float mx = wave_max(fmaxf(sc[0], fmaxf(sc[1], sc[2])));
        float den = 0.f;
#pragma unroll
        for (int u = 0; u < 3; ++u) { const int m = F.lane + 64 * u; const float e = (sc[u] > -1e29f) ? __builtin_amdgcn_exp2f(sc[u] - mx) : 0.f; if (m < 132) ps[m] = e; den += e; }
        den = wave_sum(den);
        LDS_WAIT(); asm volatile("" ::: "memory");
        const int mmax = p < 128 ? p : 128; float a0 = 0.f, a1 = 0.f;
        for (int m = 0; m <= mmax; ++m) { const unsigned vw = *(const unsigned*)(V + (size_t)(row - m * dil) * 512 + h * 128 + 2 * F.lane); const float pv = ps[m]; a0 += pv * bflo(vw); a1 += pv * bfhi(vw); }
        const float inv = 1.0f / den;
        bf16* og = (bf16*)(a.ws + WS_R + (size_t)(3 * g) * 16 * MiB);
        *(unsigned*)(og + (size_t)row * 512 + h * 128 + 2 * F.lane) = pk2(a0 * inv, a1 * inv);
        if (F.lane == 0) ((float*)(a.ws + WS_LSE))[((size_t)g * MTOK + row) * 4 + h] = mx + __builtin_log2f(den);
        LDS_WAIT(); asm volatile("" ::: "memory");
    }
}
typedef unsigned u32x4_t __attribute__((ext_vector_type(4)));
typedef float f32x2c_t __attribute__((ext_vector_type(2))); typedef __bf16 bf16x2c_t __attribute__((ext_vector_type(2)));
__device__ __forceinline__ unsigned pk2c(float lo, float hi) { f32x2c_t v = {lo, hi}; bf16x2c_t b = __builtin_convertvector(v, bf16x2c_t); return __builtin_bit_cast(unsigned, b); }
typedef short s16x4_t __attribute__((ext_vector_type(4)));
__device__ __forceinline__ unsigned off_b(unsigned row, unsigned ch) { return 256u * row + 16u * (ch ^ (((row & 3u) << 2) | ((row >> 2) & 3u))); }
__device__ __forceinline__ s16x4_t lds_tr16(LAS unsigned char* p) { return __builtin_bit_cast(s16x4_t, __builtin_amdgcn_ds_read_tr16_b64_v4i16((LAS s16x4_t*)p)); }
__device__ __forceinline__ void phase_attn(const Frame& F, const Args& a) {
    LAS unsigned char* Kimg = F.lds; LAS unsigned char* Vimg = F.lds + 65536; LAS float* bt = (LAS float*)(F.lds + MISC_OFF + 256);
    const float* abias = (const float*)(a.ws + WS_ABIAS);
    const int lane = F.lane, w = F.wave, l15 = lane & 15, g4 = lane >> 4;
    for (int u = F.vcu; u < 1536; u += F.G) {
        const int g = u >> 9, rem = u & 511, b = rem >> 6, h = (rem >> 4) & 3, blk = rem & 15, sh = 2 * g, nbl = 16 >> sh, r = blk / nbl, n = blk % nbl;
        const bf16* Q = (const bf16*)(a.ws + WS_R + (size_t)(3 * g + 0) * 16 * MiB) + h * 128; const bf16* K = (const bf16*)(a.ws + WS_R + (size_t)(3 * g + 1) * 16 * MiB) + h * 128;
        const bf16* V = (const bf16*)(a.ws + WS_R + (size_t)(3 * g + 2) * 16 * MiB) + h * 128;
        const size_t rowb = (size_t)b * SEQ;
        __syncthreads();
        {
            const int ch = F.tid & 15, rb = F.tid >> 4, i0 = (n == 0) ? 4 : 0;
            v4u kr[8], vr[8];
#pragma unroll
            for (int i = 0; i < 8; ++i) if (i >= i0) { const int kj = rb + 32 * i; const size_t row = rowb + (size_t)((((n - 1) * 128 + kj) << sh) + r);
                kr[i] = *(const v4u*)(K + row * 512 + ch * 8); vr[i] = *(const v4u*)(V + row * 512 + ch * 8); }
#pragma unroll
            for (int i = 0; i < 8; ++i) if (i >= i0) { const unsigned o = off_b((unsigned)(rb + 32 * i), (unsigned)ch);
                *(LAS v4u*)(Kimg + o) = kr[i]; *(LAS v4u*)(Vimg + o) = vr[i]; }
            if (F.tid < 132) bt[F.tid] = abias[(g * 4 + h) * 132 + F.tid];
        }
        __syncthreads();
        const int qi = 16 * w + l15; const size_t qrow = rowb + (size_t)(((n * 128 + qi) << sh) + r);
        bf16x8 qf[4];
#pragma unroll
        for (int ks = 0; ks < 4; ++ks) qf[ks] = *(const bf16x8*)(Q + qrow * 512 + 32 * ks + 8 * g4);
        f32x4 O[8];
#pragma unroll
        for (int eb = 0; eb < 8; ++eb) O[eb] = (f32x4){0.f, 0.f, 0.f, 0.f};
        float m_run = -1e30f, l_run = 0.f;
        const int c_lo = (n == 0) ? 4 : (w >> 1), c_hi = (w >> 1) + 4;
        const unsigned trq = (unsigned)(l15 >> 2), trp = (unsigned)(lane & 3);
        for (int c = c_lo; c <= c_hi; ++c) {
            f32x4 sA = (f32x4){0.f, 0.f, 0.f, 0.f}, sB = (f32x4){0.f, 0.f, 0.f, 0.f};
#pragma unroll
            for (int ks = 0; ks < 4; ++ks) {
                const bf16x8 ka = *(const LAS bf16x8*)(Kimg + off_b((unsigned)(32 * c + l15), (unsigned)(4 * ks + g4)));
                const bf16x8 kb = *(const LAS bf16x8*)(Kimg + off_b((unsigned)(32 * c + 16 + l15), (unsigned)(4 * ks + g4)));
                sA = __builtin_amdgcn_mfma_f32_16x16x32_bf16(ka, qf[ks], sA, 0, 0, 0);
                sB = __builtin_amdgcn_mfma_f32_16x16x32_bf16(kb, qf[ks], sB, 0, 0, 0);
            }
            const int mA0 = 128 + qi - (32 * c + 4 * g4);
            float tmax = -1e30f;
#pragma unroll
            for (int rg = 0; rg < 4; ++rg) {
                const int ma = mA0 - rg, mb = ma - 16;
                const float ba = bt[ma < 0 ? 0 : (ma > 128 ? 128 : ma)], bb = bt[mb < 0 ? 0 : (mb > 128 ? 128 : mb)];
                sA[rg] = (ma >= 0 && ma <= 128) ? sA[rg] + ba : -1e30f;
                sB[rg] = (mb >= 0 && mb <= 128) ? sB[rg] + bb : -1e30f;
                tmax = fmaxf(tmax, fmaxf(sA[rg], sB[rg]));
            }
            tmax = fmaxf(tmax, __shfl_xor(tmax, 16)); tmax = fmaxf(tmax, __shfl_xor(tmax, 32));
            const float m_new = fmaxf(m_run, tmax), alpha = __builtin_amdgcn_exp2f(m_run - m_new);
            float psum = 0.f;
#pragma unroll
            for (int rg = 0; rg < 4; ++rg) { sA[rg] = __builtin_amdgcn_exp2f(sA[rg] - m_new); sB[rg] = __builtin_amdgcn_exp2f(sB[rg] - m_new); psum += sA[rg] + sB[rg]; }
            l_run = l_run * alpha + psum; m_run = m_new;
            u32x4_t pw; pw.x = pk2c(sA[0], sA[1]); pw.y = pk2c(sA[2], sA[3]); pw.z = pk2c(sB[0], sB[1]); pw.w = pk2c(sB[2], sB[3]);
            const bf16x8 pf = __builtin_bit_cast(bf16x8, pw);
            const unsigned r0 = (unsigned)(32 * c + 4 * g4) + trq;
#pragma unroll
            for (int eb = 0; eb < 8; ++eb) {
                const s16x4_t v0 = lds_tr16(Vimg + off_b(r0, (unsigned)(2 * eb) + (trp >> 1)) + 8 * (trp & 1));
                const s16x4_t v1 = lds_tr16(Vimg + off_b(r0 + 16, (unsigned)(2 * eb) + (trp >> 1)) + 8 * (trp & 1));
                const bf16x8 vf = (bf16x8){v0[0], v0[1], v0[2], v0[3], v1[0], v1[1], v1[2], v1[3]};
                O[eb] = O[eb] * alpha;
                O[eb] = __builtin_amdgcn_mfma_f32_16x16x32_bf16(vf, pf, O[eb], 0, 0, 0);
            }
        }
        float l = l_run; l += __shfl_xor(l, 16); l += __shfl_xor(l, 32);
        const float inv = 1.0f / l;
        bf16* og = (bf16*)(a.ws + WS_R + (size_t)(3 * g) * 16 * MiB) + qrow * 512 + h * 128 + 4 * g4;
#pragma unroll
        for (int eb = 0; eb < 8; ++eb) { const unsigned lo = pk2c(O[eb][0] * inv, O[eb][1] * inv), hi = pk2c(O[eb][2] * inv, O[eb][3] * inv);
            *(unsigned long long*)(og + 16 * eb) = (unsigned long long)lo | ((unsigned long long)hi << 32); }
        if (g4 == 0) ((float*)(a.ws + WS_LSE))[((size_t)g * MTOK + qrow) * 4 + h] = m_run + __builtin_log2f(l);
    }
    __syncthreads();
}
__device__ __forceinline__ void phase_merge(const Frame& F, const Args& a) {
    GRID_WAVES(F);
    const float* lse = (const float*)(a.ws + WS_LSE); bf16* att = (bf16*)(a.ws + WS_ATT);
    for (int row = gw; row < MTOK; row += NGW) {
        const int h = F.lane >> 4; float l[3], mx = -1e30f;
#pragma unroll
        for (int g = 0; g < 3; ++g) { l[g] = lse[((size_t)g * MTOK + row) * 4 + h]; mx = fmaxf(mx, l[g]); }
        float w[3], ws_ = 0.f;
#pragma unroll
        for (int g = 0; g < 3; ++g) { w[g] = __builtin_amdgcn_exp2f(l[g] - mx); ws_ += w[g]; }
        const float inv = 1.0f / ws_; float o[8];
#pragma unroll
        for (int j = 0; j < 8; ++j) o[j] = 0.f;
#pragma unroll
        for (int g = 0; g < 3; ++g) { const v4u v = *(const v4u*)((const bf16*)(a.ws + WS_R + (size_t)(3 * g) * 16 * MiB) + (size_t)row * 512 + F.lane * 8); const float wg = w[g] * inv;
            o[0] += wg * bflo(v.x); o[1] += wg * bfhi(v.x); o[2] += wg * bflo(v.y); o[3] += wg * bfhi(v.y); o[4] += wg * bflo(v.z); o[5] += wg * bfhi(v.z); o[6] += wg * bflo(v.w); o[7] += wg * bfhi(v.w); }
        v4u r; r.x = pk2(o[0], o[1]); r.y = pk2(o[2], o[3]); r.z = pk2(o[4], o[5]); r.w = pk2(o[6], o[7]);
        *(v4u*)(att + (size_t)row * 512 + F.lane * 8) = r;
    }
    const float* modf = (const float*)(a.ws + WS_MODF); const bf16* w1t = (const bf16*)(a.ws + WS_WFF1); float* bias5 = (float*)(a.ws + WS_BIAS5);
    for (int n = gw; n < DFF; n += NGW) {
        float wv[16];
        { const v4u w0 = *(const v4u*)(w1t + (size_t)n * DM + 16 * F.lane), w1 = *(const v4u*)(w1t + (size_t)n * DM + 16 * F.lane + 8);
          wv[0] = bflo(w0.x); wv[1] = bfhi(w0.x); wv[2] = bflo(w0.y); wv[3] = bfhi(w0.y); wv[4] = bflo(w0.z); wv[5] = bfhi(w0.z); wv[6] = bflo(w0.w); wv[7] = bfhi(w0.w);
          wv[8] = bflo(w1.x); wv[9] = bfhi(w1.x); wv[10] = bflo(w1.y); wv[11] = bfhi(w1.y); wv[12] = bflo(w1.z); wv[13] = bfhi(w1.z); wv[14] = bflo(w1.w); wv[15] = bfhi(w1.w); }
        for (int b = 0; b < 8; ++b) { const f32x4* sp = (const f32x4*)(modf + b * 6144 + 3 * 1024 + 16 * F.lane); float s = 0.f;
#pragma unroll
            for (int q = 0; q < 4; ++q) { const f32x4 sv = sp[q]; s += sv.x * wv[4 * q] + sv.y * wv[4 * q + 1] + sv.z * wv[4 * q + 2] + sv.w * wv[4 * q + 3]; }
            s = wave_sum(s);
            if (F.lane == 0) bias5[b * 4096 + n] = s; }
    }
}
__device__ __forceinline__ void phase_ret_naive(const Frame& F, const Args& a) {
    LAS float* qs = (LAS float*)F.lds; LAS float* ks = qs + 256; LAS float* red = ks + 256;
    const bf16* RQ = (const bf16*)(a.ws + WS_R + 16 * MiB); const bf16* RK = (const bf16*)(a.ws + WS_R + 64 * MiB); bf16* RV = (bf16*)a.out;
    float2* gns = (float2*)(a.ws + WS_GNS);
    for (int u = F.vcu; u < 256; u += F.G) {
        const int b = u >> 5, h = (u >> 3) & 3, es = u & 7, e = F.tid & 63, dg = F.tid >> 6;
        const float lg = __builtin_log2f(1.0f - __builtin_amdgcn_exp2f(-5.0f - (float)h)), cd = __builtin_amdgcn_exp2f(128.0f * lg);
        float T[32];
#pragma unroll
        for (int i = 0; i < 32; ++i) T[i] = 0.f;
        for (int s = 0; s < SEQ; ++s) {
            const size_t row = (size_t)b * SEQ + s;
            __syncthreads();
            if (F.tid < 256) qs[F.tid] = bf2f(RQ[row * 1024 + h * 256 + F.tid]); else ks[F.tid - 256] = bf2f(RK[row * 1024 + h * 256 + F.tid - 256]);
            const float vv = bf2f(RV[row * 2048 + h * 512 + es * 64 + e]);
            __syncthreads();
            float part = 0.f;
#pragma unroll
            for (int i = 0; i < 32; ++i) { const int d = dg * 32 + i; T[i] = fmaf(ks[d], vv, T[i]); part = fmaf(qs[d], T[i], part); }
            red[dg * 64 + e] = part;
            __syncthreads();
            if (F.tid < 64) { float o = 0.f;
#pragma unroll
                for (int j = 0; j < 8; ++j) o += red[j * 64 + F.tid];
                RV[row * 2048 + h * 512 + es * 64 + F.tid] = (bf16)pk2(o, 0.f);
                const float s1 = wave_sum(o), s2 = wave_sum(o * o);
                if (F.tid == 0) { gns[(row * 4 + h) * 16 + es * 2] = make_float2(s1, s2); gns[(row * 4 + h) * 16 + es * 2 + 1] = make_float2(0.f, 0.f); } }
            if ((s & 127) == 127) {
#pragma unroll
                for (int i = 0; i < 32; ++i) T[i] *= cd; }
        }
    }
    __syncthreads();
}
typedef float f32x16_t __attribute__((ext_vector_type(16)));
constexpr int RL_QH = 0, RL_KH = 32768, RL_V = 65536, RL_P = 81920, RL_ST = 114688;
__device__ __forceinline__ unsigned off_v(unsigned row, unsigned ch) { return 128u * row + 16u * (ch ^ ((row & 2u) << 1)); }
__device__ __forceinline__ unsigned off_st(unsigned row, unsigned ch) { return 512u * row + 16u * (ch ^ (row & 15u)); }
__device__ __forceinline__ bf16x8 ret_vfrag(LAS unsigned char* L, int ks, int sub, int h5, unsigned trq, unsigned trp, unsigned trb, unsigned oz) {
    const unsigned r0 = (unsigned)(16 * ks + 8 * h5) + trq + oz, chv = (unsigned)(4 * sub) + 2 * trb + (trp >> 1);
    const s16x4_t t0 = lds_tr16(L + RL_V + off_v(r0, chv) + 8 * (trp & 1)), t1 = lds_tr16(L + RL_V + off_v(r0 + 4, chv) + 8 * (trp & 1));
    return (bf16x8){t0[0], t0[1], t0[2], t0[3], t1[0], t1[1], t1[2], t1[3]};
}
__device__ __forceinline__ void phase_ret(const Frame& F, const Args& a) {
    LAS unsigned char* L = F.lds;
    const bf16* RQ = (const bf16*)(a.ws + WS_R + 16 * MiB); const bf16* RK = (const bf16*)(a.ws + WS_R + 64 * MiB); bf16* RV = (bf16*)a.out;
    float2* gns = (float2*)(a.ws + WS_GNS);
    const int lane = F.lane, w = F.wave, l31 = lane & 31, h5 = lane >> 5, ib = w >> 1, sub = w & 1;
    const unsigned trq = (unsigned)((lane & 15) >> 2), trp = (unsigned)(lane & 3), trb = (unsigned)((lane >> 4) & 1);
    const int sch = F.tid & 15, srb = F.tid >> 4, vch = F.tid & 7, vrb = F.tid >> 3;
    LAS float* ostg = (LAS float*)(L + RL_QH + w * 4224);
    for (int u = F.vcu; u < 256; u += F.G) {
        const int b = u >> 5, h = (u >> 3) & 3, es = u & 7;
        const float lg = __builtin_log2f(1.0f - __builtin_amdgcn_exp2f(-5.0f - (float)h)), cd = __builtin_amdgcn_exp2f(128.0f * lg);
        const size_t rowb = (size_t)b * SEQ;
        const bf16* gq = RQ + (rowb + srb) * 1024 + h * 256 + sch * 8; const bf16* gk = RK + (rowb + srb) * 1024 + h * 256 + sch * 8;
        bf16* gv = RV + (rowb + vrb) * 2048 + h * 512 + es * 64 + vch * 8;
        f32x16_t Sst[2];
#pragma unroll
        for (int i = 0; i < 16; ++i) { Sst[0][i] = 0.f; Sst[1][i] = 0.f; }
        v4u qr[4], kr[4], vr[2];
#define RET_LOADQK(c_, hh_) do { _Pragma("unroll") for (int i_ = 0; i_ < 4; ++i_) { const size_t g_ = ((size_t)(c_) * 128 + 32 * i_) * 1024 + (hh_) * 128; qr[i_] = *(const v4u*)(gq + g_); kr[i_] = *(const v4u*)(gk + g_); } } while (0)
#define RET_LOADV(c_) do { _Pragma("unroll") for (int i_ = 0; i_ < 2; ++i_) vr[i_] = *(const v4u*)(gv + ((size_t)(c_) * 128 + 64 * i_) * 2048); } while (0)
#define RET_WRITEQK() do { _Pragma("unroll") for (int i_ = 0; i_ < 4; ++i_) { const unsigned o_ = off_b((unsigned)(srb + 32 * i_), (unsigned)sch); *(LAS v4u*)(L + RL_QH + o_) = qr[i_]; *(LAS v4u*)(L + RL_KH + o_) = kr[i_]; } } while (0)
#define RET_WRITEV() do { _Pragma("unroll") for (int i_ = 0; i_ < 2; ++i_) *(LAS v4u*)(L + RL_V + off_v((unsigned)(vrb + 64 * i_), (unsigned)vch)) = vr[i_]; } while (0)
        RET_LOADQK(0, 0); RET_LOADV(0);
        __syncthreads();
        for (int i = F.tid; i < 2048; i += NWAVES * 64) *(LAS v4u*)(L + RL_ST + 16 * i) = (v4u){0u, 0u, 0u, 0u};
        RET_WRITEQK(); RET_WRITEV();
        for (int c = 0; c < 16; ++c) {
            const size_t row0 = rowb + (size_t)c * 128;
            unsigned oz = 0u; asm volatile("" : "+v"(oz));
            f32x16_t Sacc[2], Oacc;
#pragma unroll
            for (int i = 0; i < 16; ++i) { Sacc[0][i] = 0.f; Sacc[1][i] = 0.f; Oacc[i] = 0.f; }
#pragma unroll
            for (int hh = 0; hh < 2; ++hh) {
                __syncthreads();
                if (hh == 0) RET_LOADQK(c, 1); else if (c < 15) { RET_LOADQK(c + 1, 0); RET_LOADV(c + 1); }
#pragma unroll 2
                for (int s = 0; s < 8; ++s) {
                    const bf16x8 qf = *(const LAS bf16x8*)(L + RL_QH + off_b((unsigned)(32 * ib + l31) + oz, (unsigned)(2 * s + h5)));
#pragma unroll
                    for (int jj = 0; jj < 2; ++jj) { const int jb = 2 * sub + jj;
                        if (jb <= ib) { const bf16x8 kf = *(const LAS bf16x8*)(L + RL_KH + off_b((unsigned)(32 * jb + l31) + oz, (unsigned)(2 * s + h5)));
                            Sacc[jj] = __builtin_amdgcn_mfma_f32_32x32x16_bf16(kf, qf, Sacc[jj], 0, 0, 0); } }
                    const bf16x8 sf = *(const LAS bf16x8*)(L + RL_ST + off_st((unsigned)(32 * sub + l31) + oz, (unsigned)(16 * hh + 2 * s + h5)));
                    Oacc = __builtin_amdgcn_mfma_f32_32x32x16_bf16(qf, sf, Oacc, 0, 0, 0);
                }
#pragma unroll 2
                for (int ks = 0; ks < 8; ++ks) { const unsigned r0 = (unsigned)(16 * ks + 8 * h5) + trq + oz, chk = (unsigned)(4 * ib) + 2 * trb + (trp >> 1);
                    const s16x4_t t0 = lds_tr16(L + RL_KH + off_b(r0, chk) + 8 * (trp & 1)), t1 = lds_tr16(L + RL_KH + off_b(r0 + 4, chk) + 8 * (trp & 1));
                    const bf16x8 kt = (bf16x8){t0[0], t0[1], t0[2], t0[3], t1[0], t1[1], t1[2], t1[3]};
                    Sst[hh] = __builtin_amdgcn_mfma_f32_32x32x16_bf16(kt, ret_vfrag(L, ks, sub, h5, trq, trp, trb, oz), Sst[hh], 0, 0, 0); }
#pragma unroll
                for (int i = 0; i < 16; ++i) Sst[hh][i] *= cd;
                if (hh == 1) {
#pragma unroll
                    for (int jj = 0; jj < 2; ++jj) { const int jb = 2 * sub + jj;
                        if (jb <= ib) {
#pragma unroll
                            for (int rg = 0; rg < 4; ++rg) { float p[4];
#pragma unroll
                                for (int e = 0; e < 4; ++e) { const int jin = 8 * rg + 4 * h5 + e; p[e] = (jb < ib || jin <= l31) ? Sacc[jj][4 * rg + e] : 0.f; }
                                *(LAS unsigned long long*)(L + RL_P + off_b((unsigned)(32 * ib + l31), (unsigned)(4 * jb + rg)) + 8 * h5) = (unsigned long long)pk2c(p[0], p[1]) | ((unsigned long long)pk2c(p[2], p[3]) << 32); } } }
                }
                __syncthreads();
#pragma unroll
                for (int rg = 0; rg < 4; ++rg)
                    *(LAS unsigned long long*)(L + RL_ST + off_st((unsigned)(32 * sub + l31), (unsigned)(16 * hh + 4 * ib + rg)) + 8 * h5) =
                        (unsigned long long)pk2c(Sst[hh][4 * rg], Sst[hh][4 * rg + 1]) | ((unsigned long long)pk2c(Sst[hh][4 * rg + 2], Sst[hh][4 * rg + 3]) << 32);
                if (hh == 0) RET_WRITEQK();
            }
#pragma unroll
            for (int s = 0; s < 8; ++s) if (s < 2 * (ib + 1)) { const bf16x8 pf = *(const LAS bf16x8*)(L + RL_P + off_b((unsigned)(32 * ib + l31), (unsigned)(2 * s + h5)));
                Oacc = __builtin_amdgcn_mfma_f32_32x32x16_bf16(pf, ret_vfrag(L, s, sub, h5, trq, trp, trb, oz), Oacc, 0, 0, 0); }
#pragma unroll
            for (int rg = 0; rg < 4; ++rg)
#pragma unroll
                for (int e = 0; e < 4; ++e) ostg[(8 * rg + 4 * h5 + e) * 33 + l31] = Oacc[4 * rg + e];
            asm volatile("s_waitcnt lgkmcnt(0)" ::: "memory");
            { float ov[16]; float s1 = 0.f, s2 = 0.f;
#pragma unroll
              for (int e = 0; e < 16; ++e) { ov[e] = ostg[l31 * 33 + 16 * h5 + e]; s1 += ov[e]; s2 += ov[e] * ov[e]; }
              s1 += __shfl_xor(s1, 32); s2 += __shfl_xor(s2, 32);
              const size_t orow = row0 + 32 * ib + l31;
              v4u o0, o1; o0.x = pk2c(ov[0], ov[1]); o0.y = pk2c(ov[2], ov[3]); o0.z = pk2c(ov[4], ov[5]); o0.w = pk2c(ov[6], ov[7]);
              o1.x = pk2c(ov[8], ov[9]); o1.y = pk2c(ov[10], ov[11]); o1.z = pk2c(ov[12], ov[13]); o1.w = pk2c(ov[14], ov[15]);
              bf16* op = RV + orow * 2048 + h * 512 + es * 64 + 32 * sub + 16 * h5;
              *(v4u*)op = o0; *(v4u*)(op + 8) = o1;
              if (h5 == 0) gns[(orow * 4 + h) * 16 + es * 2 + sub] = make_float2(s1, s2); }
            __syncthreads();
            if (c < 15) { RET_WRITEQK(); RET_WRITEV(); }
        }
    }
#undef RET_LOADQK
#undef RET_LOADV
#undef RET_WRITEQK
#undef RET_WRITEV
}
__device__ __forceinline__ void phase_gn(const Frame& F, const Args& a) {
    GRID_WAVES(F);
    const float2* gns = (const float2*)(a.ws + WS_GNS); const bf16* ro = (const bf16*)(a.ws + WS_R); bf16* sg = (bf16*)(a.ws + WS_R + 64 * MiB);
    const float* gg = a.in[7]; const float* gb = a.in[8];
    for (int row = gw; row < MTOK; row += NGW) {
        const float2 st = gns[(size_t)row * 64 + F.lane]; float s1 = st.x, s2 = st.y;
#pragma unroll
        for (int o = 1; o < 16; o <<= 1) { s1 += __shfl_xor(s1, o); s2 += __shfl_xor(s2, o); }
        const float mu = s1 * (1.0f / 512.0f), var = fmaxf(s2 * (1.0f / 512.0f) - mu * mu, 0.f), rstd = 1.0f / sqrtf(var + 1e-5f);
#pragma unroll
        for (int c = 0; c < 4; ++c) {
            const float muh = __shfl(mu, 16 * c), rsh = __shfl(rstd, 16 * c); const int col = (F.lane + 64 * c) * 8;
            const v4u rv = *(const v4u*)(ro + (size_t)row * 2048 + col), gv = *(const v4u*)(sg + (size_t)row * 2048 + col);
            const f32x4 g0 = *(const f32x4*)(gg + col), g1 = *(const f32x4*)(gg + col + 4), b0 = *(const f32x4*)(gb + col), b1 = *(const f32x4*)(gb + col + 4);
            float o[8]; const float r[8] = {bflo(rv.x), bfhi(rv.x), bflo(rv.y), bfhi(rv.y), bflo(rv.z), bfhi(rv.z), bflo(rv.w), bfhi(rv.w)};
            const float s[8] = {bflo(gv.x), bfhi(gv.x), bflo(gv.y), bfhi(gv.y), bflo(gv.z), bfhi(gv.z), bflo(gv.w), bfhi(gv.w)};
            const float gq[8] = {g0.x, g0.y, g0.z, g0.w, g1.x, g1.y, g1.z, g1.w}, bq[8] = {b0.x, b0.y, b0.z, b0.w, b1.x, b1.y, b1.z, b1.w};
#pragma unroll
            for (int j = 0; j < 8; ++j) o[j] = s[j] * ((r[j] - muh) * rsh * gq[j] + bq[j]);
            v4u w; w.x = pk2(o[0], o[1]); w.y = pk2(o[2], o[3]); w.z = pk2(o[4], o[5]); w.w = pk2(o[6], o[7]);
            *(v4u*)(sg + (size_t)row * 2048 + col) = w;
        }
    }
}
__device__ __forceinline__ void phase_final(const Frame& F, const Args& a) {
    GRID_WAVES(F);
    const float* rowp = (const float*)(a.ws + WS_ROWP2); const float* gf = a.in[15];
    for (int row = gw; row < MTOK; row += NGW) {
        float s = (F.lane < 16) ? rowp[(size_t)row * 16 + F.lane] : 0.f;
        s = wave_sum(s);
        const float rstd = 1.0f / sqrtf(s * (1.0f / DM) + 1e-6f);
        GAS f32x4* xr = (GAS f32x4*)(a.out + (size_t)row * DM) + F.lane;
#pragma unroll
        for (int j = 0; j < 4; ++j) { const f32x4 g = *(const f32x4*)(gf + 4 * F.lane + 256 * j); xr[64 * j] = xr[64 * j] * rstd * g; }
    }
}
#ifndef MK_PER_PHASE
#define MK_PER_PHASE 0
#endif
constexpr int N_PHASES = 12;
__global__ void __launch_bounds__(NWAVES * 64, 2) mega_fwd(Args args) {
    extern __shared__ __attribute__((aligned(16))) unsigned char lds_raw[];
    Frame F;
    F.lds = (LAS unsigned char*)lds_raw;
    F.tid = threadIdx.x; F.lane = F.tid & 63; F.wave = __builtin_amdgcn_readfirstlane(F.tid >> 6);
    F.G = gridDim.x; { const int bx = blockIdx.x; F.vcu = (F.G % 8 == 0) ? (bx % 8) * (F.G / 8) + bx / 8 : bx; }
    volatile LAS unsigned* MISC = (volatile LAS unsigned*)(F.lds + MISC_OFF);
    if (F.tid < 64) MISC[F.tid] = 0u;
    __syncthreads();
    unsigned char* ws = args.ws; unsigned char* dob = (unsigned char*)args.out;
    cg::grid_group grid = cg::this_grid();
    XcdBarrier bar; bar.bar = (unsigned*)(ws + WS_CTL) + CW_BAR; bar.x = 0; bar.st = nullptr;
    if (!MK_PER_PHASE) bar = xcd_barrier_post((unsigned*)(ws + WS_CTL) + CW_BAR, MISC + 8);
    const int lo = args.ph_lo, hi = args.ph_hi;
    if (hi < 0) grid.sync();
#define IN(k) (lo <= (k) && (k) < hi)
#define SEAM(k) do { if (IN(k) && IN((k) + 1)) { xcd_barrier(bar); } } while (0)
    typedef pg8::bf16_t b16;
    b16* HB = (b16*)(ws + WS_HB); const b16* WIN = (const b16*)(ws + WS_WIN);
    const float* modf = (const float*)(ws + WS_MODF);

    if (IN(0)) { phase_p0(F, args); } SEAM(0);
    if (IN(1)) { phase_p1(F, args); } SEAM(1);
    if (IN(2)) {
        pg8::Gemm g{HB, WIN + (size_t)6144 * DM, MTOK, 4608, DM, 1 << 30, 0}; pg8::StaticOrder S; S.init(MTOK, 4608, F.G, (int)blockIdx.x);
        pg8::EpiProj<0> E{(b16*)(ws + WS_R), nullptr, nullptr, nullptr, nullptr, nullptr, nullptr, nullptr};
        pg8::gemm_phase<pg8::EpiProj<0>, pg8::StaticOrder, true, true>(F.lds, g, S, E);
    } SEAM(2);
    if (IN(3)) { phase_attn(F, args); } SEAM(3);
    if (IN(4)) {
        phase_merge(F, args);
        pg8::Gemm g{HB, WIN, MTOK, 4096, DM, 1 << 30, 0}; pg8::StaticOrder S; S.init(MTOK, 4096, F.G, (int)blockIdx.x);
        pg8::EpiProj<1> E{(b16*)(ws + WS_R + 16 * MiB), (b16*)(ws + WS_R + 64 * MiB), (b16*)dob, nullptr, (const float*)(ws + WS_ROPE), nullptr, nullptr, nullptr};
        pg8::gemm_phase<pg8::EpiProj<1>, pg8::StaticOrder, true, true>(F.lds, g, S, E);
    } SEAM(4);
    if (IN(5)) { phase_ret(F, args); } SEAM(5);
    if (IN(6)) {
        { pg8::Gemm g{HB, WIN + (size_t)4096 * DM, MTOK, 2048, DM, 1 << 30, 0}; pg8::StaticOrder S; S.init(MTOK, 2048, F.G, (int)blockIdx.x);
          pg8::EpiProj<2> E{nullptr, nullptr, (b16*)dob, (b16*)(ws + WS_R), nullptr, (const float*)(ws + WS_GNS), args.in[7], args.in[8]};
          pg8::gemm_phase<pg8::EpiProj<2>, pg8::StaticOrder, true, true>(F.lds, g, S, E); }
        { pg8::Gemm g{HB, WIN + (size_t)10752 * DM, MTOK, 2048, DM, 1 << 30, 0}; pg8::StaticOrder S; S.init(MTOK, 2048, F.G, (int)blockIdx.x);
          pg8::EpiProj<3> E{(b16*)(ws + WS_R + 64 * MiB), (b16*)(ws + WS_R + 96 * MiB), nullptr, nullptr, nullptr, nullptr, nullptr, nullptr};
          pg8::gemm_phase<pg8::EpiProj<3>, pg8::StaticOrder, true, true>(F.lds, g, S, E); }
    } SEAM(6);
    if (IN(7)) {
        pg8::Gemm g{(const b16*)(ws + WS_ATT), (const b16*)(ws + WS_WATT), MTOK, DM, 512, 1 << 30, 0}; pg8::StaticOrder S; S.init(MTOK, DM, F.G, (int)blockIdx.x);
        pg8::EpiT3 E{(const b16*)(ws + WS_R + 96 * MiB), (b16*)dob};
        pg8::gemm_phase<pg8::EpiT3, pg8::StaticOrder, true, true>(F.lds, g, S, E);
        pg8::Gemm g2{(const b16*)(ws + WS_R), (const b16*)(ws + WS_WRET), MTOK, DM, 2048, 1 << 30, 0};
        pg8::EpiMerged E2{(const b16*)(ws + WS_R + 64 * MiB), (const b16*)dob, HB};
        pg8::gemm_phase<pg8::EpiMerged, pg8::StaticOrder, true, true>(F.lds, g2, S, E2);
    } SEAM(7);
    if (IN(8)) {
        pg8::Gemm g{HB, (const b16*)(ws + WS_WO), MTOK, DM, DM, 1 << 30, 0}; pg8::StaticOrder S; S.init(MTOK, DM, F.G, (int)blockIdx.x);
        pg8::EpiX1 E{args.in[0], modf, args.in[12], args.out, (b16*)(ws + WS_R), (float*)(ws + WS_ROWP)};
        pg8::gemm_phase<pg8::EpiX1, pg8::StaticOrder, true, true>(F.lds, g, S, E);
    } SEAM(8);
    if (IN(9)) {
        pg8::Gemm g{(const b16*)(ws + WS_R), (const b16*)(ws + WS_WFF1), MTOK, DFF, DM, 1 << 30, 0}; pg8::StaticOrder S; S.init(MTOK, DFF, F.G, (int)blockIdx.x);
        pg8::EpiFF1 E{(const float*)(ws + WS_ROWP), (const float*)(ws + WS_BIAS5), (b16*)(ws + WS_R + 32 * MiB)};
        pg8::gemm_phase<pg8::EpiFF1, pg8::StaticOrder, true, true>(F.lds, g, S, E);
    } SEAM(9);
    if (IN(10)) {
        pg8::Gemm g{(const b16*)(ws + WS_R + 32 * MiB), (const b16*)(ws + WS_WFF2), MTOK, DM, DFF, 1 << 30, 0}; pg8::StaticOrder S; S.init(MTOK, DM, F.G, (int)blockIdx.x);
        pg8::EpiX2 E{modf, args.out, (float*)(ws + WS_ROWP2)};
        pg8::gemm_phase<pg8::EpiX2, pg8::StaticOrder, true, true>(F.lds, g, S, E);
    } SEAM(10);
    if (IN(11)) { phase_final(F, args); }
#undef IN
#undef SEAM
}


extern "C" void kernel_launch(void* const* d_in, const int* in_sizes, int n_in, void* d_out, int out_size, void* d_ws, size_t ws_size, hipStream_t stream) {
    static int grid = 0;
    if (grid == 0) {
        if (n_in != 16 || out_size != MTOK * DM || ws_size < WS_END) { fprintf(stderr, "kernel_launch: unexpected shapes (n_in %d out %d ws %zu)\n", n_in, out_size, ws_size); grid = -1; return; }
        int dev = 0, cus = 0, per_cu = 0;
        (void)hipGetDevice(&dev); (void)hipDeviceGetAttribute(&cus, hipDeviceAttributeMultiprocessorCount, dev);
        if (hipFuncSetAttribute((const void*)mega_fwd, hipFuncAttributeMaxDynamicSharedMemorySize, LDS_BYTES) != hipSuccess) { fprintf(stderr, "kernel_launch: hipFuncSetAttribute failed\n"); grid = -1; return; }
        if (hipOccupancyMaxActiveBlocksPerMultiprocessor(&per_cu, (const void*)mega_fwd, NWAVES * 64, LDS_BYTES) != hipSuccess || per_cu < 1) { fprintf(stderr, "kernel_launch: occupancy query says %d\n", per_cu); (void)hipGetLastError(); per_cu = 1; }
        grid = cus;
        if (grid != 256) fprintf(stderr, "kernel_launch: %d CUs; the phase program assumes 256\n", grid);
    }
    if (grid < 0) return;
    (void)hipMemsetAsync((char*)d_ws + WS_CTL, 0, CTL_ZERO_BYTES, stream);
    Args a{};
    for (int i = 0; i < 16; ++i) a.in[i] = (const float*)d_in[i];
    a.out = (float*)d_out; a.ws = (unsigned char*)d_ws;
#if MK_PER_PHASE
    for (int p = 0; p < N_PHASES; ++p) { a.ph_lo = p; a.ph_hi = p + 1; hipLaunchKernelGGL(mega_fwd, dim3(grid), dim3(NWAVES * 64), LDS_BYTES, stream, a); }
#else
    a.ph_lo = 0; a.ph_hi = N_PHASES;
    void* kargs[] = {&a};
    const hipError_t e = hipLaunchCooperativeKernel((const void*)mega_fwd, dim3(grid), dim3(NWAVES * 64), kargs, LDS_BYTES, stream);
    if (e != hipSuccess) fprintf(stderr, "kernel_launch: cooperative launch failed: %s (grid %d)\n", hipGetErrorString(e), grid);
#endif
}
```
